# Optimizing an MI355X kernel written in HIP

```python
import jax
import jax.numpy as jnp
from jax import lax
import numpy as np

D_MODEL = 2048
BATCH = 4
SEQ = 4096
DEPTH = 2

GRID_W = 64
CTX_LEN = 256
EPS = 1e-6
NEG_INF = -1e30

CONV_CH = D_MODEL // 4
CONV_K = 31
NA_HEADS = 16
NA_HD = D_MODEL // 32
NA_DIM = NA_HEADS * NA_HD
NA_KH_MAX = 8
NA_KW = 16
NA_QB = 16
NA_KB = 32
HG_HEADS = 4
HG_DK = D_MODEL // 16
HG_DV = HG_DK
HG_DIM = HG_HEADS * HG_DK
HG_CHUNK = 64
MIX_DIM = CONV_CH + NA_DIM + HG_DIM
OFF_NA = 2 * CONV_CH
OFF_HG = OFF_NA + 3 * NA_DIM
IN_DIM = OFF_HG + 5 * HG_DIM
N_GROUPS = 4
EXP_PER_GROUP = 8
N_EXPERTS = N_GROUPS * EXP_PER_GROUP
TOP_K = 2
D_EXPERT = D_MODEL // 4
MOE_BLOCK = 128

kernel_name = "hybrid_conv_natten_hgrn2_hmoe_dit"


def _rmsnorm(x, g):
    xf = x.astype(jnp.float32)
    y = xf * lax.rsqrt(jnp.mean(xf * xf, axis=-1, keepdims=True) + EPS)
    return (y * g.astype(jnp.float32)).astype(x.dtype)


def _layernorm(x, g, b):
    xf = x.astype(jnp.float32)
    mu = jnp.mean(xf, axis=-1, keepdims=True)
    var = jnp.mean(jnp.square(xf - mu), axis=-1, keepdims=True)
    y = (xf - mu) * lax.rsqrt(var + EPS) * g.astype(jnp.float32) + b.astype(jnp.float32)
    return y.astype(x.dtype)


def _conv_module(u, w_dw, b_dw, ln_g, ln_b):
    a, gate = jnp.split(u, 2, axis=-1)
    h = a * jax.nn.sigmoid(gate)
    h = lax.conv_general_dilated(
        h, w_dw[:, None, :].astype(h.dtype), window_strides=(1,),
        padding=[(CONV_K // 2, CONV_K // 2)],
        dimension_numbers=("NWC", "WIO", "NWC"), feature_group_count=CONV_CH)
    h = h + b_dw.astype(h.dtype)
    return jax.nn.silu(_layernorm(h, ln_g, ln_b))


def _na_col_tables():
    nb = GRID_W // NA_QB
    qcol = np.arange(GRID_W).reshape(nb, NA_QB)
    kstart = np.clip(np.arange(nb) * NA_QB - NA_KW // 2, 0, GRID_W - NA_KB)
    kcol = kstart[:, None] + np.arange(NA_KB)[None, :]
    wstart = np.clip(qcol - NA_KW // 2, 0, GRID_W - NA_KW)
    dcol = kcol[:, None, :] - qcol[:, :, None]
    ok = (kcol[:, None, :] >= wstart[:, :, None]) & (kcol[:, None, :] < wstart[:, :, None] + NA_KW)
    dcol_idx = np.clip(dcol + NA_KW - 1, 0, 2 * NA_KW - 2)
    return kcol, dcol_idx, ok


def _na_latent(q, k, v, kc, vc, rpb):
    B, T, H, hd = q.shape
    rows = T // GRID_W
    kh = min(NA_KH_MAX, rows)
    nb = GRID_W // NA_QB
    kcol, dcol_idx, ok = _na_col_tables()
    scale = hd ** -0.5
    col_bias = jnp.where(ok, rpb.astype(jnp.float32)[:, :, dcol_idx], NEG_INF)
    qg = jnp.moveaxis(q.reshape(B, rows, nb, NA_QB, H, hd), 1, 0)
    kg = k.reshape(B, rows, GRID_W, H, hd)
    vg = v.reshape(B, rows, GRID_W, H, hd)

    def row_block(args):
        r, q_r = args
        sr = jnp.clip(r - kh // 2, 0, rows - kh)
        k_b = lax.dynamic_slice_in_dim(kg, sr, kh, axis=1)[:, :, kcol]
        v_b = lax.dynamic_slice_in_dim(vg, sr, kh, axis=1)[:, :, kcol]
        drow = sr + jnp.arange(kh) - r
        bias = jnp.take(col_bias, drow + NA_KH_MAX - 1, axis=1).transpose(0, 2, 3, 1, 4)
        s_win = jnp.einsum("bjqhd,brjkhd->bhjqrk", q_r, k_b).astype(jnp.float32) * scale + bias[None]
        s_ctx = jnp.einsum("bjqhd,bchd->bhjqc", q_r, kc).astype(jnp.float32) * scale
        s = jnp.concatenate([s_win.reshape(B, H, nb, NA_QB, kh * NA_KB), s_ctx], axis=-1)
        p = jax.nn.softmax(s, axis=-1).astype(v.dtype)
        p_win = p[..., : kh * NA_KB].reshape(B, H, nb, NA_QB, kh, NA_KB)
        p_ctx = p[..., kh * NA_KB:]
        return (jnp.einsum("bhjqrk,brjkhd->bjqhd", p_win, v_b)
                + jnp.einsum("bhjqc,bchd->bjqhd", p_ctx, vc))

    o = lax.map(row_block, (jnp.arange(rows), qg))
    return jnp.moveaxis(o, 0, 1).reshape(B, T, H * hd)


def _ctx_attn(q, k, v):
    B, L, H, hd = q.shape
    s = jnp.einsum("bqhd,bkhd->bhqk", q, k).astype(jnp.float32) * hd ** -0.5
    p = jax.nn.softmax(s, axis=-1).astype(v.dtype)
    return jnp.einsum("bhqk,bkhd->bqhd", p, v).reshape(B, L, H * hd)


def _heads(a):
    B, T, _ = a.shape
    return a.astype(jnp.float32).reshape(B, T, HG_HEADS, -1).transpose(0, 2, 1, 3)


def _hgrn_gates(z, lb):
    logf = jnp.logaddexp(jnp.log(lb), jnp.log1p(-lb) + jax.nn.log_sigmoid(z))
    return logf, -jnp.expm1(logf)


def _hgrn_scan(q, k, v, logf, s0):
    B, H, T, DK = q.shape
    DV = v.shape[-1]
    n = T // HG_CHUNK

    def chunks(a):
        return a.reshape(B, H, n, HG_CHUNK, a.shape[-1]).transpose(2, 0, 1, 3, 4)

    tri = jnp.tril(jnp.ones((HG_CHUNK, HG_CHUNK), dtype=bool))[:, :, None]

    def step(S, inp):
        qc, kc, vc, lf = inp
        b = jnp.cumsum(lf, axis=2)
        diff = b[:, :, :, None, :] - b[:, :, None, :, :]
        decay = jnp.exp(jnp.where(tri, diff, -jnp.inf))
        att = jnp.einsum("bhtk,bhsk,bhtsk->bhts", qc, kc, decay)
        o = (jnp.einsum("bhts,bhsv->bhtv", att, vc)
             + jnp.einsum("bhtk,bhkv->bhtv", qc * jnp.exp(b), S))
        b_last = b[:, :, -1, :]
        S = (jnp.exp(b_last)[..., None] * S
             + jnp.einsum("bhsk,bhsv->bhkv", kc * jnp.exp(b_last[:, :, None, :] - b), vc))
        return S, o

    S, o = lax.scan(step, s0, (chunks(q), chunks(k), chunks(v), chunks(logf)))
    return o.transpose(1, 2, 0, 3, 4).reshape(B, H, T, DV), S


def _hgrn_readout(o, g, norm_g):
    B, H, T, DV = o.shape
    o = o * lax.rsqrt(jnp.mean(o * o, axis=-1, keepdims=True) + EPS)
    o = o.transpose(0, 2, 1, 3).reshape(B, T, H * DV) * norm_g.astype(jnp.float32)
    return (o * jax.nn.silu(g.astype(jnp.float32))).astype(g.dtype)


def _hgrn_branch(ul, uc, lb, norm_g, with_ctx):
    def prep(u):
        q, i, zf, zb, g = jnp.split(u, 5, axis=-1)
        return jax.nn.silu(_heads(q)), _heads(i), _heads(zf), _heads(zb), g

    ql, il, zfl, zbl, gl = prep(ul)
    qc, ic, zfc, zbc, gc = prep(uc)
    lb = lb.astype(jnp.float32)
    lb_f = lb[0].reshape(HG_HEADS, 1, HG_DK)
    lb_b = lb[1].reshape(HG_HEADS, 1, HG_DK)
    s0 = jnp.zeros((ul.shape[0], HG_HEADS, HG_DK, HG_DV), jnp.float32)

    def flip(a):
        return a[:, :, ::-1]

    lf, kf = _hgrn_gates(zfc, lb_f)
    oc_f, sc_f = _hgrn_scan(qc, kf, ic, lf, s0)
    lf, kf = _hgrn_gates(zfl, lb_f)
    ol_f, _ = _hgrn_scan(ql, kf, il, lf, sc_f)
    lbk, kb = _hgrn_gates(flip(zbc), lb_b)
    oc_b, sc_b = _hgrn_scan(flip(qc), kb, flip(ic), lbk, s0)
    lbk, kb = _hgrn_gates(flip(zbl), lb_b)
    ol_b, _ = _hgrn_scan(flip(ql), kb, flip(il), lbk, sc_b)

    out_l = _hgrn_readout(ol_f + flip(ol_b), gl, norm_g)
    out_c = _hgrn_readout(oc_f + flip(oc_b), gc, norm_g) if with_ctx else None
    return out_l, out_c


def _hier_moe(h, w_rg, b_rg, w_re, b_re, w1, w3, w2):
    N, D = h.shape
    pg = jax.nn.softmax((h @ w_rg).astype(jnp.float32) + b_rg.astype(jnp.float32), axis=-1)
    p_grp, grp = lax.top_k(pg, 1)
    le = ((h @ w_re).astype(jnp.float32) + b_re.astype(jnp.float32)).reshape(N, N_GROUPS, EXP_PER_GROUP)
    le = jnp.take_along_axis(le, grp[:, :, None], axis=1)[:, 0]
    p_exp, idx = lax.top_k(jax.nn.softmax(le, axis=-1), TOP_K)
    p_exp = p_exp / jnp.sum(p_exp, axis=-1, keepdims=True)
    eid = (grp * EXP_PER_GROUP + idx).reshape(-1).astype(jnp.int32)
    wt = (p_grp * p_exp).reshape(-1)
    A = N * TOP_K
    tok = jnp.arange(A, dtype=jnp.int32) // TOP_K
    nblk = -(-A // MOE_BLOCK) + N_EXPERTS
    P = nblk * MOE_BLOCK
    cnt = jax.ops.segment_sum(jnp.ones((A,), jnp.int32), eid, num_segments=N_EXPERTS)
    pcnt = (cnt + MOE_BLOCK - 1) // MOE_BLOCK * MOE_BLOCK
    pend = jnp.cumsum(pcnt)
    pstart = pend - pcnt
    start = jnp.cumsum(cnt) - cnt
    order = jnp.argsort(eid)
    se = eid[order]
    dst = pstart[se] + (jnp.arange(A, dtype=jnp.int32) - start[se])
    slot_tok = jnp.full((P,), N, jnp.int32).at[dst].set(tok[order])
    slot_w = jnp.zeros((P,), jnp.float32).at[dst].set(wt[order])
    blk_e = jnp.minimum(jnp.searchsorted(pend, jnp.arange(nblk, dtype=jnp.int32) * MOE_BLOCK, side="right"),
                        N_EXPERTS - 1)
    hpad = jnp.concatenate([h, jnp.zeros((1, D), h.dtype)], axis=0)
    xs = hpad[slot_tok].reshape(nblk, MOE_BLOCK, D)

    def expert_block(args):
        e, xb = args
        return (jax.nn.silu(xb @ w1[e]) * (xb @ w3[e])) @ w2[e]

    ys = lax.map(expert_block, (blk_e, xs)).reshape(P, D)
    ys = ys * slot_w.astype(ys.dtype)[:, None]
    return jax.ops.segment_sum(ys, slot_tok, num_segments=N + 1)[:N]


def setup_inputs(seed: int = 0) -> dict:
    key = jax.random.key(seed)
    ks = jax.random.split(key, 26)
    f32 = jnp.float32
    D = D_MODEL
    inv = D ** -0.5

    def nrm(k, shape, s):
        return jax.random.normal(k, shape, f32) * s

    return {
        "x": nrm(ks[0], (BATCH, SEQ, D), 1.0),
        "c": nrm(ks[1], (BATCH, D), 1.0),
        "ctx": nrm(ks[2], (BATCH, CTX_LEN, D), 1.0),
        "c_ctx": nrm(ks[3], (D,), 1.0),
        "w_ada": nrm(ks[4], (DEPTH, D, 6 * D), 0.5 * inv),
        "b_ada": nrm(ks[5], (DEPTH, 6 * D), 0.02),
        "g_mix": 1.0 + nrm(ks[6], (DEPTH, D), 0.02),
        "g_ffn": 1.0 + nrm(ks[7], (DEPTH, D), 0.02),
        "w_in": nrm(ks[8], (DEPTH, D, IN_DIM), inv),
        "conv_w": nrm(ks[9], (DEPTH, CONV_K, CONV_CH), CONV_K ** -0.5),
        "conv_b": nrm(ks[10], (DEPTH, CONV_CH), 0.02),
        "conv_ln_g": 1.0 + nrm(ks[11], (DEPTH, CONV_CH), 0.02),
        "conv_ln_b": nrm(ks[12], (DEPTH, CONV_CH), 0.02),
        "na_rpb": nrm(ks[13], (DEPTH, NA_HEADS, 2 * NA_KH_MAX - 1, 2 * NA_KW - 1), 0.1),
        "hgrn_lb": nrm(ks[14], (DEPTH, 2, HG_DIM), 0.5),
        "hgrn_norm_g": 1.0 + nrm(ks[15], (DEPTH, HG_DIM), 0.02),
        "w_out": nrm(ks[16], (DEPTH, MIX_DIM, D), MIX_DIM ** -0.5),
        "w_router_group": nrm(ks[17], (DEPTH, D, N_GROUPS), inv),
        "b_router_group": nrm(ks[18], (DEPTH, N_GROUPS), 0.01),
        "w_router_expert": nrm(ks[19], (DEPTH, D, N_EXPERTS), inv),
        "b_router_expert": nrm(ks[20], (DEPTH, N_EXPERTS), 0.01),
        "w_exp_gate": nrm(ks[21], (DEPTH, N_EXPERTS, D, D_EXPERT), inv),
        "w_exp_up": nrm(ks[22], (DEPTH, N_EXPERTS, D, D_EXPERT), inv),
        "w_exp_down": nrm(ks[23], (DEPTH, N_EXPERTS, D_EXPERT, D), D_EXPERT ** -0.5),
        "g_final": 1.0 + nrm(ks[24], (D,), 0.02),
    }


def reference(x, c, ctx, c_ctx, w_ada, b_ada, g_mix, g_ffn, w_in, conv_w, conv_b, conv_ln_g,
              conv_ln_b, na_rpb, hgrn_lb, hgrn_norm_g, w_out, w_router_group, b_router_group,
              w_router_expert, b_router_expert, w_exp_gate, w_exp_up, w_exp_down, g_final):
    B, T, D = x.shape
    L = ctx.shape[1]
    lbs = jnp.cumsum(jax.nn.softmax(hgrn_lb.astype(jnp.float32), axis=0), axis=0)
    lbs = lbs - lbs[:1]
    sc_lat = jax.nn.silu(c)
    sc_ctx = jax.nn.silu(c_ctx)
    xl, xc = x, ctx
    for l in range(DEPTH):
        with_ctx = l < DEPTH - 1
        mod_l = (sc_lat @ w_ada[l] + b_ada[l])[:, None, :]
        mod_c = (sc_ctx @ w_ada[l] + b_ada[l])[None, None, :]
        sh1_l, s1_l, ga1_l, sh2_l, s2_l, ga2_l = jnp.split(mod_l, 6, axis=-1)
        sh1_c, s1_c, ga1_c, sh2_c, s2_c, ga2_c = jnp.split(mod_c, 6, axis=-1)

        hl = _rmsnorm(xl, g_mix[l]) * (1.0 + s1_l) + sh1_l
        hc = _rmsnorm(xc, g_mix[l]) * (1.0 + s1_c) + sh1_c
        ul = hl @ w_in[l]
        uc = hc @ w_in[l]

        conv_l = _conv_module(ul[..., :OFF_NA], conv_w[l], conv_b[l], conv_ln_g[l], conv_ln_b[l])

        qa, ka, va = [a.reshape(B, T, NA_HEADS, NA_HD) for a in jnp.split(ul[..., OFF_NA:OFF_HG], 3, axis=-1)]
        qcx, kcx, vcx = [a.reshape(B, L, NA_HEADS, NA_HD) for a in jnp.split(uc[..., OFF_NA:OFF_HG], 3, axis=-1)]
        na_l = _na_latent(qa, ka, va, kcx, vcx, na_rpb[l])

        hg_l, hg_c = _hgrn_branch(ul[..., OFF_HG:], uc[..., OFF_HG:], lbs[l], hgrn_norm_g[l], with_ctx)

        xl = xl + ga1_l * (jnp.concatenate([conv_l, na_l, hg_l], axis=-1) @ w_out[l])
        if with_ctx:
            conv_c = _conv_module(uc[..., :OFF_NA], conv_w[l], conv_b[l], conv_ln_g[l], conv_ln_b[l])
            na_c = _ctx_attn(qcx, kcx, vcx)
            xc = xc + ga1_c * (jnp.concatenate([conv_c, na_c, hg_c], axis=-1) @ w_out[l])

        hl = (_rmsnorm(xl, g_ffn[l]) * (1.0 + s2_l) + sh2_l).reshape(B * T, D)
        if with_ctx:
            hc = (_rmsnorm(xc, g_ffn[l]) * (1.0 + s2_c) + sh2_c).reshape(B * L, D)
            tokens = jnp.concatenate([hl, hc], axis=0)
        else:
            tokens = hl
        f = _hier_moe(tokens, w_router_group[l], b_router_group[l], w_router_expert[l],
                      b_router_expert[l], w_exp_gate[l], w_exp_up[l], w_exp_down[l])
        xl = xl + ga2_l * f[: B * T].reshape(B, T, D)
        if with_ctx:
            xc = xc + ga2_c * f[B * T:].reshape(B, L, D)
    return _rmsnorm(xl, g_final)
```

```cpp
#include <hip/hip_runtime.h>
#include <cstdio>
#include <cstdint>
namespace pg8 {
#define PG8_LAS __attribute__((address_space(3)))
typedef unsigned short bf16_t;
typedef short bf16x8 __attribute__((ext_vector_type(8)));
typedef float f32x4 __attribute__((ext_vector_type(4)));
typedef unsigned u32x4 __attribute__((ext_vector_type(4)));
typedef int v8i_t __attribute__((ext_vector_type(8)));
typedef int i32x4_t __attribute__((ext_vector_type(4)));
constexpr int BM = 256, BK = 64, HALF = 128, HTB = HALF * BK * 2  , STAGE_BYTES = 8 * HTB, NXCD = 8, WGM = 8;

__host__ __device__ __forceinline__ int lds_byte(int r, int c) { const int st = (r >> 4) * 2 + (c >> 5), rr = r & 15, cc = c & 31, ob = rr * 64 + cc * 2; return st * 1024 + (ob ^ (((ob >> 9) & 1) << 5)); }
__host__ __device__ __forceinline__ void stage_rc(int b, int& R, int& C) { const int st = b / 1024, sb = b % 1024, swz = sb ^ (((sb >> 9) & 1) << 5); R = (st >> 1) * 16 + swz / 64; C = (st & 1) * 32 + (swz % 64) / 2; }
__host__ __device__ __forceinline__ int perm32(int rho) { const int n = rho >> 4, i = rho & 15; return 8 * (i >> 2) + 4 * n + (i & 3); }


struct Unit { int pm, pn; };
struct Gemm { const bf16_t* A; const bf16_t* Bt; int M, N, K; };

struct StaticOrder {
    int nM, nN, nwg, G, c;
    __host__ __device__ void init(int M, int N, int G_, int c_) { nM = M / BM; nN = N / BM; nwg = nM * nN; G = G_; c = c_; }
    __host__ __device__ bool next(int i, Unit& u) const {
        const long L = (long)i * G + c; if (L >= nwg) return false;
        int wgid = (int)L; { const int q = nwg / NXCD, r = nwg % NXCD, xcd = wgid % NXCD, off = wgid / NXCD; wgid = (xcd < r ? xcd * (q + 1) : r * (q + 1) + (xcd - r) * q) + off; }
        const int nig = WGM * nN, gid = wgid / nig, fm = gid * WGM, gsz = (nM - fm) < WGM ? (nM - fm) : WGM;
        u.pm = fm + ((wgid % nig) % gsz); u.pn = (wgid % nig) / gsz; return true;
    }
    __device__ __forceinline__ const char* aptr(const Gemm& g, const Unit& u, size_t tstep) const { return (const char*)g.A + (size_t)u.pm * tstep; }
    __device__ __forceinline__ const char* bptr(const Gemm& g, const Unit& u, size_t tstep) const { return (const char*)g.Bt + (size_t)u.pn * tstep; }
    __device__ __forceinline__ void a_ready(const Unit&) const {}
    __device__ __forceinline__ void done(const Unit&) const {}
};
struct GroupedOrder {
    const PG8_LAS int* tile_e; int ntiles, nN, G, c; size_t estride;
    __device__ bool next(int i, Unit& u) const {
        const int x = c & 7, bi = c >> 3, nbx = G >> 3, T8 = (ntiles + 7) >> 3;
        const int lu = i * nbx + bi, pm = x * T8 + lu / nN;
        if (lu >= T8 * nN || pm >= ntiles) return false;
        u.pm = pm; u.pn = lu % nN; return true;
    }
    __device__ __forceinline__ const char* aptr(const Gemm& g, const Unit& u, size_t tstep) const { return (const char*)g.A + (size_t)u.pm * tstep; }
    __device__ __forceinline__ const char* bptr(const Gemm& g, const Unit& u, size_t tstep) const { return (const char*)g.Bt + (size_t)__builtin_amdgcn_readfirstlane(tile_e[u.pm]) * estride + (size_t)u.pn * tstep; }
    __device__ __forceinline__ void a_ready(const Unit&) const {}
    __device__ __forceinline__ void done(const Unit&) const {}
};

struct InProjOrder {
    int G, c;
    static __host__ __device__ __forceinline__ int coltile(int pn20) { return pn20 < 12 ? pn20 : (pn20 < 14 ? pn20 + 4 : pn20 + 6); }
    static __host__ __device__ __forceinline__ int wrow(int t) { return t < 4 ? 3072 + 256 * t : 4608 + 256 * (t - 4); }
    __device__ bool next(int i, Unit& u) const {
        const int L = i * G + c; if (L >= 1768) return false;
        if (L < 1360) { constexpr int nM = 68, nN = 20, nwg = 1360; int wgid = L; { const int q = nwg / NXCD, xcd = wgid % NXCD, off = wgid / NXCD; wgid = xcd * q + off; }
            const int nig = WGM * nN, gid = wgid / nig, fm = gid * WGM, gsz = (nM - fm) < WGM ? (nM - fm) : WGM;
            u.pm = fm + ((wgid % nig) % gsz); u.pn = (wgid % nig) / gsz; }
        else { const int Ls = L - 1360; u.pm = Ls / 68; u.pn = 100 + Ls % 68; }
        return true;
    }
    __device__ __forceinline__ const char* aptr(const Gemm& g, const Unit& u, size_t tstep) const {
        return u.pn >= 100 ? (const char*)g.Bt + (size_t)wrow(u.pm) * g.K * 2 : (const char*)g.A + (size_t)u.pm * tstep; }
    __device__ __forceinline__ const char* bptr(const Gemm& g, const Unit& u, size_t tstep) const {
        return u.pn >= 100 ? (const char*)g.A + (size_t)(u.pn - 100) * tstep : (const char*)g.Bt + (size_t)coltile(u.pn) * tstep; }
    __device__ __forceinline__ void a_ready(const Unit&) const {}
    __device__ __forceinline__ void done(const Unit&) const {}
};

typedef unsigned u32x2s __attribute__((ext_vector_type(2)));
typedef __bf16 bf16x2_t __attribute__((ext_vector_type(2)));
typedef float f32x2_t __attribute__((ext_vector_type(2)));
__device__ __forceinline__ unsigned cvt_pk_bf16(float lo, float hi) { const f32x2_t f = {lo, hi}; const bf16x2_t v = __builtin_convertvector(f, bf16x2_t); return __builtin_bit_cast(unsigned, v); }

__device__ __forceinline__ unsigned cvt4_fp8(float a, float b, float c, float d) {
    a = fminf(fmaxf(a, -440.f), 440.f); b = fminf(fmaxf(b, -440.f), 440.f); c = fminf(fmaxf(c, -440.f), 440.f); d = fminf(fmaxf(d, -440.f), 440.f);
    int w = 0; w = __builtin_amdgcn_cvt_pk_fp8_f32(a, b, w, false); w = __builtin_amdgcn_cvt_pk_fp8_f32(c, d, w, true); return (unsigned)w; }
constexpr float F8_SC1 = 32.f, F8_SC2 = 16.f, F8_SCY = 16.f;

struct EpiU {
    static constexpr bool PERM = true, AFTER_DRAIN = false;
    bf16_t* O; int ldc;
    __device__ __forceinline__ void operator()(const f32x4 (&acc)[2][2][4][2], const Unit& u, int wr, int wc, int fr, int fq) const {
        const int row0 = u.pm * BM + wr * 64 + fr, col0 = u.pn * BM + wc * 32 + 8 * fq;
#pragma unroll
        for (int ai = 0; ai < 2; ++ai)
#pragma unroll
            for (int m = 0; m < 4; ++m) { bf16_t* rowp = O + (size_t)(row0 + ai * HALF + m * 16) * ldc + col0;
#pragma unroll
                for (int bj = 0; bj < 2; ++bj) { const f32x4 v0 = acc[ai][bj][m][0], v1 = acc[ai][bj][m][1];
                    u32x4 w; w.x = cvt_pk_bf16(v0[0], v0[1]); w.y = cvt_pk_bf16(v0[2], v0[3]); w.z = cvt_pk_bf16(v1[0], v1[1]); w.w = cvt_pk_bf16(v1[2], v1[3]);
                    *(u32x4*)(rowp + bj * HALF) = w; } }
    }
};
struct EpiInProj {
    static constexpr bool PERM = true, AFTER_DRAIN = false;
    bf16_t* Uo; bf16_t* VT;
    __device__ __forceinline__ void operator()(const f32x4 (&acc)[2][2][4][2], const Unit& u, int wr, int wc, int fr, int fq) const {
        const bool sw = u.pn >= 100;
        if (!sw && u.pn < 4) {
            const int row0 = u.pm * BM + wr * 64 + fr, col0 = u.pn * HALF + wc * 32 + 8 * fq;
#pragma unroll
            for (int ai = 0; ai < 2; ++ai)
#pragma unroll
                for (int m = 0; m < 4; ++m) { float r[8];
#pragma unroll
                    for (int n = 0; n < 2; ++n)
#pragma unroll
                        for (int j = 0; j < 4; ++j) r[n * 4 + j] = acc[ai][0][m][n][j] * __builtin_amdgcn_rcpf(1.f + __expf(-acc[ai][1][m][n][j]));
                    u32x4 w; w.x = cvt_pk_bf16(r[0], r[1]); w.y = cvt_pk_bf16(r[2], r[3]); w.z = cvt_pk_bf16(r[4], r[5]); w.w = cvt_pk_bf16(r[6], r[7]);
                    *(u32x4*)(Uo + (size_t)(row0 + ai * HALF + m * 16) * 6656 + col0) = w; }
            return; }
        bf16_t* O = sw ? VT : Uo; const int ldc = sw ? 17408 : 6656;
        const int row0 = u.pm * BM + wr * 64 + fr, col0 = (sw ? (u.pn - 100) : InProjOrder::coltile(u.pn)) * BM + wc * 32 + 8 * fq;
#pragma unroll
        for (int ai = 0; ai < 2; ++ai)
#pragma unroll
            for (int m = 0; m < 4; ++m) { bf16_t* rowp = O + (size_t)(row0 + ai * HALF + m * 16) * ldc + col0;
#pragma unroll
                for (int bj = 0; bj < 2; ++bj) { const f32x4 v0 = acc[ai][bj][m][0], v1 = acc[ai][bj][m][1];
                    u32x4 w; w.x = cvt_pk_bf16(v0[0], v0[1]); w.y = cvt_pk_bf16(v0[2], v0[3]); w.z = cvt_pk_bf16(v1[0], v1[1]); w.w = cvt_pk_bf16(v1[2], v1[3]);
                    *(u32x4*)(rowp + bj * HALF) = w; } }
    }
};
struct EpiRes {
    static constexpr bool PERM = false, AFTER_DRAIN = false;
    const float* res0; const float* res1; float* out; const float* ga;
    __device__ __forceinline__ void operator()(const f32x4 (&acc)[2][2][4][2], const Unit& u, int wr, int wc, int fr, int fq) const {
        const int row0 = u.pm * BM + wr * 64 + fr, col0 = u.pn * BM + wc * 32 + 4 * fq;
        const bool lat = u.pm < 64; const int mr = lat ? (u.pm >> 4) : 4;
        const float* gap = ga + mr * 12288 + col0;
        const float* rp0 = (lat ? res0 + (size_t)row0 * 2048 : res1 + (size_t)(row0 - 16384) * 2048) + col0;
        float* op0 = out + (size_t)row0 * 2048 + col0;
        f32x4 gv[2][2];
#pragma unroll
        for (int bj = 0; bj < 2; ++bj)
#pragma unroll
            for (int n = 0; n < 2; ++n) gv[bj][n] = *(const f32x4*)(gap + bj * HALF + n * 16) * (1.f / F8_SC1);
#pragma unroll
        for (int ai = 0; ai < 2; ++ai)
#pragma unroll
            for (int m = 0; m < 4; ++m) { f32x4 rv[2][2];
#pragma unroll
                for (int bj = 0; bj < 2; ++bj)
#pragma unroll
                    for (int n = 0; n < 2; ++n) rv[bj][n] = *(const f32x4*)(rp0 + (size_t)(ai * HALF + m * 16) * 2048 + bj * HALF + n * 16);
                __builtin_amdgcn_sched_barrier(0);
#pragma unroll
                for (int bj = 0; bj < 2; ++bj)
#pragma unroll
                    for (int n = 0; n < 2; ++n) *(f32x4*)(op0 + (size_t)(ai * HALF + m * 16) * 2048 + bj * HALF + n * 16) = rv[bj][n] + gv[bj][n] * acc[ai][bj][m][n];
                __builtin_amdgcn_sched_barrier(0); }
    }
};
struct EpiGLU {
    static constexpr bool PERM = true, AFTER_DRAIN = false;
    unsigned char* O;
    __device__ __forceinline__ void operator()(const f32x4 (&acc)[2][2][4][2], const Unit& u, int wr, int wc, int fr, int fq) const {
        const int row0 = u.pm * BM + wr * 64 + fr, col0 = u.pn * HALF + wc * 32 + 8 * fq;
#pragma unroll
        for (int ai = 0; ai < 2; ++ai)
#pragma unroll
            for (int m = 0; m < 4; ++m) { unsigned char* rowp = O + (size_t)(row0 + ai * HALF + m * 16) * 512 + col0;
                float r[8];
#pragma unroll
                for (int n = 0; n < 2; ++n)
#pragma unroll
                    for (int j = 0; j < 4; ++j) { const float g = acc[ai][0][m][n][j] * (1.f / F8_SC1), up = acc[ai][1][m][n][j] * (1.f / F8_SC1); r[n * 4 + j] = g * up * __builtin_amdgcn_rcpf(1.f + __expf(-g)); }
                u32x2s w; w.x = cvt4_fp8(r[0], r[1], r[2], r[3]); w.y = cvt4_fp8(r[4], r[5], r[6], r[7]);
                *(u32x2s*)rowp = w; }
    }
};
struct EpiScatter {
    static constexpr bool PERM = true, AFTER_DRAIN = false;
    unsigned char* Y; const int* sdst; const float* sw;
    __device__ __forceinline__ void operator()(const f32x4 (&acc)[2][2][4][2], const Unit& u, int wr, int wc, int fr, int fq) const {
        const int row0 = u.pm * BM + wr * 64 + fr, col0 = u.pn * BM + wc * 32 + 8 * fq;
#pragma unroll
        for (int ai = 0; ai < 2; ++ai) { int dst[4]; float w[4];
#pragma unroll
            for (int m = 0; m < 4; ++m) { const int slot = row0 + ai * HALF + m * 16; dst[m] = sdst[slot]; w[m] = sw[slot] * (F8_SCY / F8_SC2); }
            __builtin_amdgcn_sched_barrier(0);
#pragma unroll
            for (int m = 0; m < 4; ++m) {
                if (dst[m] >= 0) { unsigned char* rowp = Y + (size_t)dst[m] * 2048 + col0;
#pragma unroll
                    for (int bj = 0; bj < 2; ++bj) { const f32x4 v0 = acc[ai][bj][m][0] * w[m], v1 = acc[ai][bj][m][1] * w[m];
                        u32x2s o; o.x = cvt4_fp8(v0[0], v0[1], v0[2], v0[3]); o.y = cvt4_fp8(v1[0], v1[1], v1[2], v1[3]);
                        *(u32x2s*)(rowp + bj * HALF) = o; } } }
            __builtin_amdgcn_sched_barrier(0); }
    }
};

template <class Epi, class Sched, bool ALIGN_EPI = false, bool SP2 = false, bool F8 = false>
__device__ __forceinline__ void gemm_phase(PG8_LAS unsigned char* lds, const Gemm g, const Sched& S, const Epi& E) {
    int tid_ = threadIdx.x; asm volatile("" : "+v"(tid_));
    const int tid = tid_, wid = __builtin_amdgcn_readfirstlane(tid >> 6), lane = tid & 63, wr = wid >> 2, wc = wid & 3, fr = lane & 15, fq = lane >> 4;
    const int KB = F8 ? g.K : g.K * 2, nt = KB / 128;
    unsigned voffA[2], voffB[2];
#pragma unroll
    for (int i = 0; i < 2; ++i) { int R, C; stage_rc(tid * 16 + i * 8192, R, C); const int Rb = Epi::PERM ? ((R & ~31) + perm32(R & 31)) : R;
        voffA[i] = (unsigned)(R * KB + C * 2); voffB[i] = (unsigned)(Rb * KB + C * 2); }
    const size_t kstep = (size_t)128;
    const size_t hstep = (size_t)HALF * KB;
    const size_t tstep = 2 * hstep;
    const unsigned ldsw = (unsigned)wid * 1024u;
    const int aoff = lds_byte(wr * 64 + fr, fq * 8), boff = lds_byte(wc * 32 + fr, fq * 8);
    const int aoff8a = lds_byte(wr * 64 + fr, fq * 16), boff8a = lds_byte(wc * 32 + fr, fq * 16);
#define PG8_SA(b, h) (((b) * 2 + (h)) * HTB)
#define PG8_SB(b, h) ((4 + (b) * 2 + (h)) * HTB)
#define PG8_STAGE(bufoff, gbase, voff) do { _Pragma("unroll") for (int _i = 0; _i < 2; ++_i) \
        __builtin_amdgcn_global_load_lds((const unsigned*)((const char*)(gbase) + (voff)[_i]), (PG8_LAS unsigned*)(lds + (bufoff) + ldsw + _i * 8192), 16, 0, 0); } while (0)
#define PG8_LDA(dst, b, h) do { if constexpr (F8) { _Pragma("unroll") for (int m = 0; m < 4; ++m) dst##8[m] = *(const PG8_LAS v8i_t*)(lds + PG8_SA(b, h) + aoff8a + m * 2048); } \
        else { _Pragma("unroll") for (int m = 0; m < 4; ++m) _Pragma("unroll") for (int k = 0; k < 2; ++k) dst[m][k] = *(const PG8_LAS bf16x8*)(lds + PG8_SA(b, h) + aoff + m * 2048 + k * 1024); } } while (0)
#define PG8_LDB(dst, b, h) do { if constexpr (F8) { _Pragma("unroll") for (int n = 0; n < 2; ++n) dst##8[n] = *(const PG8_LAS v8i_t*)(lds + PG8_SB(b, h) + boff8a + n * 2048); } \
        else { _Pragma("unroll") for (int n = 0; n < 2; ++n) _Pragma("unroll") for (int k = 0; k < 2; ++k) dst[n][k] = *(const PG8_LAS bf16x8*)(lds + PG8_SB(b, h) + boff + n * 2048 + k * 1024); } } while (0)
#define PG8_MMA(ai, bj, At, Bt) do { __builtin_amdgcn_s_setprio(1); if constexpr (F8) { _Pragma("unroll") for (int m = 0; m < 4; ++m) _Pragma("unroll") for (int n = 0; n < 2; ++n) \
            asm volatile("v_mfma_scale_f32_16x16x128_f8f6f4 %0, %1, %2, %0, %3, %3 op_sel_hi:[0,0,0]" : "+v"(acc[ai][bj][m][n]) : "v"(Bt##8[n]), "v"(At##8[m]), "v"(f8one)); } \
        else { _Pragma("unroll") for (int m = 0; m < 4; ++m) _Pragma("unroll") for (int n = 0; n < 2; ++n) _Pragma("unroll") for (int k = 0; k < 2; ++k) \
            acc[ai][bj][m][n] = __builtin_amdgcn_mfma_f32_16x16x32_bf16(Bt[n][k], At[m][k], acc[ai][bj][m][n], 0, 0, 0); } __builtin_amdgcn_s_setprio(0); } while (0)
#define PG8_WAIT_V(n) asm volatile("s_waitcnt vmcnt(" #n ")" ::: "memory")
#define PG8_WAIT_L(n) asm volatile("s_waitcnt lgkmcnt(" #n ")" ::: "memory")
#define PG8_BAR __builtin_amdgcn_s_barrier()
#define PG8_SCHED __builtin_amdgcn_sched_barrier(0)
    Unit cur, nxt; int ui = 0;
    if (!S.next(0, cur)) return;
    f32x4 acc[2][2][4][2];
#pragma unroll
    for (int a = 0; a < 2; ++a)
#pragma unroll
        for (int b = 0; b < 2; ++b)
#pragma unroll
            for (int m = 0; m < 4; ++m)
#pragma unroll
                for (int n = 0; n < 2; ++n) acc[a][b][m][n] = (f32x4){0.f, 0.f, 0.f, 0.f};
    bf16x8 At[4][2], B0[2][2], B1[2][2]; v8i_t At8[4], B08[2], B18[2];
    const int f8one = 0x7f7f7f7f;
    const char* cA = S.aptr(g, cur, tstep); const char* cB = S.bptr(g, cur, tstep);
    S.a_ready(cur);
    if constexpr (SP2) {
        PG8_STAGE(PG8_SB(0, 0), cB, voffB); PG8_STAGE(PG8_SB(0, 1), cB + hstep, voffB); PG8_STAGE(PG8_SA(0, 0), cA, voffA); PG8_STAGE(PG8_SA(0, 1), cA + hstep, voffA);
        if (wr == 1) PG8_BAR;
        PG8_WAIT_V(2); PG8_BAR;
        PG8_STAGE(PG8_SB(1, 0), cB + kstep, voffB); PG8_STAGE(PG8_SA(1, 0), cA + kstep, voffA); PG8_STAGE(PG8_SB(1, 1), cB + hstep + kstep, voffB);
        PG8_WAIT_V(6); PG8_BAR;
    } else {
        PG8_STAGE(PG8_SB(0, 0), cB, voffB); PG8_STAGE(PG8_SA(0, 0), cA, voffA); PG8_STAGE(PG8_SB(0, 1), cB + hstep, voffB); PG8_STAGE(PG8_SA(0, 1), cA + hstep, voffA);
        if (wr == 1) PG8_BAR;
        PG8_WAIT_V(4); PG8_BAR;
        PG8_STAGE(PG8_SB(1, 0), cB + kstep, voffB); PG8_STAGE(PG8_SA(1, 0), cA + kstep, voffA); PG8_STAGE(PG8_SB(1, 1), cB + hstep + kstep, voffB);
        PG8_WAIT_V(6); PG8_BAR;
    }
    for (;;) {
        const bool has_next = S.next(ui + 1, nxt);
        const char* nA = has_next ? S.aptr(g, nxt, tstep) : cA; const char* nB = has_next ? S.bptr(g, nxt, tstep) : cB;
        for (int t = 0; t < nt; t += 2) {
            const bool last = (t == nt - 2);
            const char* a1 = cA + (size_t)(t + 1) * kstep;
            const char* a2 = last ? nA : cA + (size_t)(t + 2) * kstep; const char* b2 = last ? nB : cB + (size_t)(t + 2) * kstep;
            const char* a3 = a2 + kstep; const char* b3 = b2 + kstep;
            if (last && has_next) S.a_ready(nxt);
            if constexpr (SP2) {
            PG8_LDB(B0, 0, 0); PG8_LDB(B1, 0, 1); PG8_SCHED; PG8_LDA(At, 0, 0); PG8_STAGE(PG8_SA(1, 1), a1 + hstep, voffA);
            PG8_WAIT_V(8); PG8_WAIT_L(0); PG8_BAR; PG8_MMA(0, 0, At, B0); PG8_MMA(0, 1, At, B1); PG8_BAR; PG8_SCHED;
            PG8_LDA(At, 0, 1); PG8_STAGE(PG8_SB(0, 0), b2, voffB); PG8_STAGE(PG8_SB(0, 1), b2 + hstep, voffB); PG8_STAGE(PG8_SA(0, 0), a2, voffA);
            PG8_WAIT_V(8); PG8_WAIT_L(0); PG8_BAR; PG8_MMA(1, 0, At, B0); PG8_MMA(1, 1, At, B1); PG8_BAR; PG8_SCHED;
            PG8_LDB(B0, 1, 0); PG8_LDB(B1, 1, 1); PG8_SCHED; PG8_LDA(At, 1, 0); PG8_STAGE(PG8_SA(0, 1), a2 + hstep, voffA);
            PG8_WAIT_V(8); PG8_WAIT_L(0); PG8_BAR; PG8_MMA(0, 0, At, B0); PG8_MMA(0, 1, At, B1); PG8_BAR; PG8_SCHED;
            PG8_LDA(At, 1, 1); PG8_STAGE(PG8_SB(1, 0), b3, voffB); PG8_STAGE(PG8_SB(1, 1), b3 + hstep, voffB); PG8_STAGE(PG8_SA(1, 0), a3, voffA);
            PG8_WAIT_V(8); PG8_WAIT_L(0); PG8_BAR; PG8_MMA(1, 0, At, B0); PG8_MMA(1, 1, At, B1); PG8_BAR; PG8_SCHED;
            } else {
            PG8_LDB(B0, 0, 0); PG8_SCHED; PG8_LDA(At, 0, 0); PG8_STAGE(PG8_SA(1, 1), a1 + hstep, voffA);
            PG8_WAIT_L(8); PG8_BAR; PG8_WAIT_L(0); PG8_MMA(0, 0, At, B0); PG8_BAR; PG8_SCHED;
            PG8_LDB(B1, 0, 1); PG8_STAGE(PG8_SB(0, 0), b2, voffB);
            PG8_BAR; PG8_WAIT_L(0); PG8_MMA(0, 1, At, B1); PG8_BAR;
            PG8_LDA(At, 0, 1); PG8_STAGE(PG8_SA(0, 0), a2, voffA);
            PG8_BAR; PG8_WAIT_L(0); PG8_MMA(1, 0, At, B0); PG8_BAR; PG8_SCHED;
            PG8_STAGE(PG8_SB(0, 1), b2 + hstep, voffB);
            PG8_WAIT_V(6); PG8_BAR; PG8_MMA(1, 1, At, B1); PG8_BAR;
            PG8_LDB(B0, 1, 0); PG8_SCHED; PG8_LDA(At, 1, 0); PG8_STAGE(PG8_SA(0, 1), a2 + hstep, voffA);
            PG8_WAIT_L(8); PG8_BAR; PG8_WAIT_L(0); PG8_MMA(0, 0, At, B0); PG8_BAR; PG8_SCHED;
            PG8_LDB(B1, 1, 1); PG8_STAGE(PG8_SB(1, 0), b3, voffB);
            PG8_BAR; PG8_WAIT_L(0); PG8_MMA(0, 1, At, B1); PG8_BAR;
            PG8_LDA(At, 1, 1); PG8_STAGE(PG8_SA(1, 0), a3, voffA);
            PG8_BAR; PG8_WAIT_L(0); PG8_MMA(1, 0, At, B0); PG8_BAR; PG8_SCHED;
            PG8_STAGE(PG8_SB(1, 1), b3 + hstep, voffB);
            PG8_WAIT_V(6); PG8_BAR; PG8_MMA(1, 1, At, B1); PG8_BAR;
            }
        }
        if constexpr (ALIGN_EPI) { if (wr == 0) PG8_BAR; }
        if constexpr (F8) { asm volatile("s_nop 15\n\ts_nop 15" ::: "memory"); }
        if constexpr (!Epi::AFTER_DRAIN) { E(acc, cur, wr, wc, fr, fq); S.done(cur); }
        if (!has_next) break;
#pragma unroll
        for (int a = 0; a < 2; ++a)
#pragma unroll
            for (int b = 0; b < 2; ++b)
#pragma unroll
                for (int m = 0; m < 4; ++m)
#pragma unroll
                    for (int n = 0; n < 2; ++n) acc[a][b][m][n] = (f32x4){0.f, 0.f, 0.f, 0.f};
        cur = nxt; cA = nA; cB = nB; ++ui;
        if constexpr (ALIGN_EPI) { if (wr == 1) PG8_BAR; }
    }
    PG8_WAIT_V(0);
    if constexpr (!ALIGN_EPI) { if (wr == 0) PG8_BAR; }
    PG8_BAR;
    if constexpr (Epi::AFTER_DRAIN) { E.fused(acc, cur, wr, wc, fr, fq, lds, wid, lane); S.done(cur); }
#undef PG8_SA
#undef PG8_SB
#undef PG8_STAGE
#undef PG8_LDA
#undef PG8_LDB
#undef PG8_MMA
#undef PG8_WAIT_V
#undef PG8_WAIT_L
#undef PG8_BAR
#undef PG8_SCHED
}
}

constexpr int D = 2048, NB = 4, SEQ_T = 4096, CTX_L = 256, DEPTH = 2;
constexpr int ML = NB * SEQ_T, MC = NB * CTX_L, MT = ML + MC;
constexpr int IN_DIM = 6656;
constexpr int OFF_CV = 0, OFF_CG = 512, OFF_Q = 1024, OFF_K = 2048, OFF_V = 3072, OFF_HQ = 4096, OFF_HI = 4608, OFF_HF = 5120, OFF_HB = 5632, OFF_HG = 6144;
constexpr int NE = 32, DE = 512;
constexpr int MOE_TILES_MAX = 168, P_MAX = MOE_TILES_MAX * 256;
constexpr float EPS = 1e-6f;
constexpr int NWAVES = 8, NTHREADS = 512;

constexpr size_t MiB = 1u << 20;
constexpr size_t WS_CTL = 0, CTL_ZERO_BYTES = 64 * 1024;
constexpr size_t WS_TAB = 2 * MiB;
constexpr size_t WS_WIN = 4 * MiB;
constexpr size_t WS_WOUT = 56 * MiB;
constexpr size_t WS_WE1 = 72 * MiB;
constexpr size_t WS_WE2 = 200 * MiB;
constexpr size_t WS_XL = 264 * MiB;
constexpr size_t WS_H = 400 * MiB;
constexpr size_t WS_U = 468 * MiB;
constexpr size_t WS_XS = WS_U;
constexpr size_t WS_ACT = WS_U + 168 * MiB;
constexpr size_t WS_CAT = 689 * MiB;
constexpr size_t WS_Y = 757 * MiB;
constexpr size_t WS_HGO = 893 * MiB;
constexpr size_t WS_VT = 961 * MiB;
constexpr size_t WS_SSTATE = 1014 * MiB;
constexpr size_t WS_RW = 1012 * MiB;
constexpr size_t WS_END = 1082 * MiB;
static_assert(WS_U + (size_t)MT * IN_DIM * 2 <= WS_CAT && WS_ACT + (size_t)P_MAX * 512 * 2 <= WS_CAT && WS_XS + (size_t)P_MAX * 2048 * 2 <= WS_ACT, "ws map");
constexpr int CW_BAR = 4096;
constexpr int CW_SB = 9216;
constexpr int CW_CNT = 8192;
constexpr int CW_MOD = 16384;
static_assert((CW_CNT + 128) * 4 <= (int)CTL_ZERO_BYTES && (CW_BAR + 3456) * 4 <= (int)CTL_ZERO_BYTES && (CW_MOD + DEPTH * 5 * 12288) * 4 <= (int)(2 * MiB), "CTL words");
constexpr size_t TB_TOKE = 0, TB_TOKW = 256 * 1024, TB_TOKP = 512 * 1024, TB_SDST = 768 * 1024, TB_SW = 1024 * 1024, TB_TILEE = 1280 * 1024, TB_NT = 1280 * 1024 + 2048, TB_RS = 1536 * 1024;

constexpr int RING_OFF = 0, RING_BYTES = 131072;
constexpr int LDSCTL_OFF = RING_BYTES, MISC_OFF = LDSCTL_OFF + 320;
constexpr int LDS_BYTES = 147456;

#define LAS __attribute__((address_space(3)))
#define GAS __attribute__((address_space(1)))
template <class T> __device__ __forceinline__ T* asglobal(T* p) { return (T*)(GAS T*)p; }
typedef unsigned short bf16;
typedef unsigned v4u __attribute__((ext_vector_type(4)));
typedef unsigned v2u __attribute__((ext_vector_type(2)));
typedef float f32x4 __attribute__((ext_vector_type(4)));
typedef short bf16x8 __attribute__((ext_vector_type(8)));
#define LDS_WAIT() asm volatile("s_waitcnt lgkmcnt(0)" ::: "memory")
#define VM_WAIT() asm volatile("s_waitcnt vmcnt(0)" ::: "memory")
__device__ __forceinline__ float bf2f(unsigned b16) { return __uint_as_float(b16 << 16); }
__device__ __forceinline__ float bflo(unsigned w) { return __uint_as_float(w << 16); }
__device__ __forceinline__ float bfhi(unsigned w) { return __uint_as_float(w & 0xffff0000u); }
__device__ __forceinline__ unsigned f2bf(float f) { unsigned u = __float_as_uint(f); return (u + 0x7fffu + ((u >> 16) & 1u)) >> 16; }
__device__ __forceinline__ unsigned pk2(float lo, float hi) { return pg8::cvt_pk_bf16(lo, hi); }
__device__ __forceinline__ f32x4 un4_fp8(int w) { const pg8::f32x2_t a = __builtin_amdgcn_cvt_pk_f32_fp8(w, false), b = __builtin_amdgcn_cvt_pk_f32_fp8(w, true); return (f32x4){a.x, a.y, b.x, b.y}; }
__device__ __forceinline__ float sigm(float x) { return __builtin_amdgcn_rcpf(1.f + __expf(-x)); }
__device__ __forceinline__ float silu(float x) { return x * __builtin_amdgcn_rcpf(1.f + __expf(-x)); }
__device__ __forceinline__ float fast_log(float x) { return __builtin_amdgcn_logf(x) * 0.69314718056f; }
__device__ __forceinline__ float wave_sum(float v) {
#pragma unroll
    for (int o = 1; o < 64; o <<= 1) v += __shfl_xor(v, o);
    return v;
}
__device__ __forceinline__ float wave_max(float v) {
#pragma unroll
    for (int o = 1; o < 64; o <<= 1) v = fmaxf(v, __shfl_xor(v, o));
    return v;
}

#define XB_TMO      128
#define XB_XCNT(j)  (256  + 64 * (j))
#define XB_XSUB(j)  (1280 + 64 * (j))
#define XB_XGEN(j)  (2304 + 64 * (j))
#define XB_TOP      3328
#define XB_TOPGEN   3392
#define XCD_BAR_WORDS 3456
#define XB_SPIN_CAP (1u << 18)

__device__ __forceinline__ unsigned xb_ld(unsigned* p)              { return __hip_atomic_load(p, __ATOMIC_RELAXED, __HIP_MEMORY_SCOPE_AGENT); }
__device__ __forceinline__ unsigned xb_add(unsigned* p, unsigned v) { return __hip_atomic_fetch_add(p, v, __ATOMIC_RELAXED, __HIP_MEMORY_SCOPE_AGENT); }
__device__ __forceinline__ unsigned xb_xcc_id() { return (unsigned)__builtin_amdgcn_s_getreg((3 << 11) | 20) & 0xFu; }
#define XB_SPIN(cond, bar) do { unsigned _sp = 0; while (cond) { __builtin_amdgcn_s_sleep(1); \
    if ((++_sp & 255u) == 0u) { if (xb_ld(&(bar)[XB_TMO])) break; if (_sp > XB_SPIN_CAP) { atomicAdd(&(bar)[XB_TMO], 1u); break; } } } } while (0)

struct XcdBarrier {
    unsigned* bar; unsigned x;
    volatile LAS unsigned* st;
};

__device__ __forceinline__ XcdBarrier xcd_barrier_post(unsigned* bar, volatile LAS unsigned* st) {
    XcdBarrier b; b.bar = bar; b.x = xb_xcc_id(); b.st = st;
    if (threadIdx.x == 0) (void)xb_add(&bar[XB_XCNT(b.x)], 1u);
    return b;
}
__device__ __forceinline__ void xcd_barrier_complete(unsigned* bar, unsigned x, unsigned& nloc, unsigned& nx) {
    const unsigned G = gridDim.x * gridDim.y * gridDim.z;
    unsigned sum, cnt, mine, sp = 0u;
    for (;;) {
        sum = 0u; cnt = 0u; mine = 0u;
#pragma unroll
        for (unsigned j = 0; j < 16; ++j) { const unsigned c = xb_ld(&bar[XB_XCNT(j)]); sum += c; cnt += (c > 0u) ? 1u : 0u; mine = (j == x) ? c : mine; }
        if (sum == G) break;
        __builtin_amdgcn_s_sleep(1);
        if ((++sp & 255u) == 0u) { if (xb_ld(&bar[XB_TMO])) break; if (sp > XB_SPIN_CAP) { atomicAdd(&bar[XB_TMO], 1u); break; } }
    }
    nloc = mine > 0u ? mine : 1u; nx = cnt > 0u ? cnt : 1u;
}

__device__ __forceinline__ void xcd_barrier(const XcdBarrier& b) {
    asm volatile("s_waitcnt vmcnt(0)" ::: "memory");
    __syncthreads();
    if (threadIdx.x == 0) {
        unsigned* bar = b.bar;
        __builtin_amdgcn_s_waitcnt(0);
        unsigned nloc = b.st[0], nx = b.st[1];
        if (nloc == 0u) { xcd_barrier_complete(bar, b.x, nloc, nx); b.st[0] = nloc; b.st[1] = nx; }
        const unsigned old = xb_add(&bar[XB_XSUB(b.x)], 1u);
        const unsigned gen = old / nloc;
        if (old + 1u == (gen + 1u) * nloc) {
            __builtin_amdgcn_fence(__ATOMIC_RELEASE, "agent");
            asm volatile("s_waitcnt vmcnt(0)" ::: "memory");
            const unsigned og = xb_add(&bar[XB_TOP], 1u);
            const unsigned tg = og / nx;
            if (og + 1u == (tg + 1u) * nx) xb_add(&bar[XB_TOPGEN], 1u);
            else XB_SPIN(xb_ld(&bar[XB_TOPGEN]) == tg, bar);
            __builtin_amdgcn_fence(__ATOMIC_ACQUIRE, "agent");
            xb_add(&bar[XB_XGEN(b.x)], 1u);
            asm volatile("s_waitcnt vmcnt(0)" ::: "memory");
        } else {
            XB_SPIN(xb_ld(&bar[XB_XGEN(b.x)]) == gen, bar);
            __builtin_amdgcn_fence(__ATOMIC_ACQUIRE, "agent");
            asm volatile("s_waitcnt vmcnt(0)" ::: "memory");
        }
    }
    __syncthreads();
}

__device__ __forceinline__ void sb_arrive(unsigned* w) {
    asm volatile("s_waitcnt vmcnt(0)" ::: "memory");
    __syncthreads();
    if (threadIdx.x == 0) { __builtin_amdgcn_fence(__ATOMIC_RELEASE, "agent"); asm volatile("s_waitcnt vmcnt(0)" ::: "memory"); (void)xb_add(w, 1u); }
}
__device__ __forceinline__ void sb_wait(unsigned* w, unsigned need, unsigned* bar) {
    if (threadIdx.x == 0) { XB_SPIN(xb_ld(w) < need, bar); __builtin_amdgcn_fence(__ATOMIC_ACQUIRE, "agent"); asm volatile("s_waitcnt vmcnt(0)" ::: "memory"); }
    __syncthreads();
}

struct Args { const float* in[25]; float* out; unsigned char* ws; int ph_lo, ph_hi; };
enum { I_X = 0, I_C, I_CTX, I_CCTX, I_WADA, I_BADA, I_GMIX, I_GFFN, I_WIN, I_CONVW, I_CONVB, I_CLNG, I_CLNB, I_RPB, I_HLB, I_HNG, I_WOUT, I_WRG, I_BRG, I_WRE, I_BRE, I_WEG, I_WEU, I_WED, I_GFIN };

struct Ctx {
    LAS unsigned char* lds;
    int tid, lane, wave, G, gw, NGW;
    unsigned char* ws;
    float* mod;
};
constexpr int ARGS_OFF = MISC_OFF + 128, TILE_LDS_OFF = ARGS_OFF + 256;
__device__ __forceinline__ const float* argp(const Ctx& C, int i) {
    int o = ARGS_OFF + 8 * i; asm volatile("" : "+v"(o));
    const LAS unsigned* t = (const LAS unsigned*)(C.lds + o);
    const unsigned lo = __builtin_amdgcn_readfirstlane(t[0]), hi = __builtin_amdgcn_readfirstlane(t[1]);
    return (const float*)(C.ws + (((unsigned long long)hi << 32) | lo));
}
#define AIN(i) argp(C, (i))
__device__ __forceinline__ const float* modp(const Ctx& C, int l, int r, int chunk) { return C.mod + (size_t)(l * 5 + r) * 12288 + chunk * 2048; }

__device__ __forceinline__ void ph_mod(const Args& a, const Ctx& C) {
    const float* c = AIN(I_C); const float* cctx = AIN(I_CCTX); const float* w_ada = AIN(I_WADA); const float* b_ada = AIN(I_BADA);
    LAS float* red = (LAS float*)(C.lds + RING_OFF);
    for (int unit = blockIdx.x; unit < DEPTH * 96; unit += C.G) {
        const int l = unit / 96, nc = unit % 96;
        const int n0 = nc * 128 + C.lane * 2, k0 = C.wave * 256;
        float acc[5][2];
#pragma unroll
        for (int r = 0; r < 5; ++r) { acc[r][0] = 0.f; acc[r][1] = 0.f; }
        const float* wp = w_ada + ((size_t)l * 2048 + k0) * 12288 + n0;
        for (int kb = 0; kb < 256; kb += 16) {
            float2 w[16];
#pragma unroll
            for (int u = 0; u < 16; ++u) w[u] = *(const float2*)(wp + (size_t)(kb + u) * 12288);
            __builtin_amdgcn_sched_barrier(0);
#pragma unroll
            for (int u = 0; u < 16; ++u) { const int k = kb + u; float s[5];
#pragma unroll
                for (int r = 0; r < 4; ++r) s[r] = silu(c[r * 2048 + k0 + k]);
                s[4] = silu(cctx[k0 + k]);
#pragma unroll
                for (int r = 0; r < 5; ++r) { acc[r][0] += s[r] * w[u].x; acc[r][1] += s[r] * w[u].y; } }
        }
#pragma unroll
        for (int r = 0; r < 5; ++r) { red[(C.wave * 5 + r) * 128 + C.lane * 2] = acc[r][0]; red[(C.wave * 5 + r) * 128 + C.lane * 2 + 1] = acc[r][1]; }
        __syncthreads();
        for (int idx = C.tid; idx < 5 * 128; idx += NTHREADS) { const int r = idx >> 7, col = idx & 127; float s = b_ada[(size_t)l * 12288 + nc * 128 + col];
#pragma unroll
            for (int w = 0; w < 8; ++w) s += red[(w * 5 + r) * 128 + col];
            C.mod[(size_t)(l * 5 + r) * 12288 + nc * 128 + col] = s; }
        __syncthreads();
    }
}

constexpr float CAT_NA_SC = 8.f;
constexpr int CONV_SCR = 8704;
struct TrItem { const float* W; int N, k0, n0; bf16* WT; int K, drow0; float f8scale; };
__device__ __forceinline__ void tr_load(const TrItem& t, f32x4 (&v)[8], int lane) {
    const int kr = lane >> 3, nc = lane & 7;
#pragma unroll
    for (int i = 0; i < 8; ++i) v[i] = *(const f32x4*)(t.W + (size_t)(t.k0 + 8 * i + kr) * t.N + t.n0 + 4 * nc);
}
__device__ __forceinline__ void tr_store(const TrItem& t, const f32x4 (&v)[8], LAS float* scr, int lane) {
    const int kr = lane >> 3, nc = lane & 7;
    LDS_WAIT(); asm volatile("" ::: "memory");
#pragma unroll
    for (int i = 0; i < 8; ++i) { LAS float* d = scr + (8 * i + kr) * 33 + 4 * nc; d[0] = v[i].x; d[1] = v[i].y; d[2] = v[i].z; d[3] = v[i].w; }
    LDS_WAIT(); asm volatile("" ::: "memory");
    const int c = lane & 7;
    if (t.f8scale != 0.f) { const float sc = t.f8scale; unsigned char* W8 = (unsigned char*)t.WT;
#pragma unroll
        for (int j = 0; j < 4; ++j) { const int n = (lane >> 3) + 8 * j; const LAS float* s = scr + (8 * c) * 33 + n;
            v2u o; o.x = pg8::cvt4_fp8(s[0 * 33] * sc, s[1 * 33] * sc, s[2 * 33] * sc, s[3 * 33] * sc); o.y = pg8::cvt4_fp8(s[4 * 33] * sc, s[5 * 33] * sc, s[6 * 33] * sc, s[7 * 33] * sc);
            *(v2u*)(W8 + (size_t)(t.drow0 + n) * t.K + t.k0 + 8 * c) = o; }
        return; }
#pragma unroll
    for (int j = 0; j < 4; ++j) { const int n = (lane >> 3) + 8 * j; const LAS float* s = scr + (8 * c) * 33 + n;
        v4u o; o.x = pk2(s[0 * 33], s[1 * 33]); o.y = pk2(s[2 * 33], s[3 * 33]); o.z = pk2(s[4 * 33], s[5 * 33]); o.w = pk2(s[6 * 33], s[7 * 33]);
        *(v4u*)(t.WT + (size_t)(t.drow0 + n) * t.K + t.k0 + 8 * c) = o; }
}
__device__ __forceinline__ TrItem dense_item(const Ctx& C, int it) {
    constexpr int I_IN = 32 * 208, I_OUT = 32 * 64;
    const int l = it / (I_IN + I_OUT); int r = it % (I_IN + I_OUT); TrItem t; t.f8scale = 0.f;
    if (r < I_IN) { const int kb = r / 208, nb = r % 208;
        const int n0 = 32 * nb, np = n0 & 511;
        t.W = AIN(I_WIN) + (size_t)l * 2048 * IN_DIM; t.N = IN_DIM; t.k0 = 64 * kb; t.n0 = n0; t.WT = (bf16*)(C.ws + WS_WIN) + (size_t)l * IN_DIM * 2048; t.K = 2048;
        t.drow0 = n0 < 1024 ? 256 * (np >> 7) + (np & 127) + (n0 >= 512 ? 128 : 0) : n0; }
    else { r -= I_IN; const int kb = r / 64, nb = r % 64;
        t.W = AIN(I_WOUT) + (size_t)l * 2048 * 2048; t.N = 2048; t.k0 = 64 * kb; t.n0 = 32 * nb; t.WT = (bf16*)(C.ws + WS_WOUT + (size_t)l * 2048 * 2048); t.K = 2048; t.drow0 = 32 * nb;
        t.f8scale = (64 * kb >= 512 && 64 * kb < 1536) ? pg8::F8_SC1 / CAT_NA_SC : pg8::F8_SC1; }
    return t;
}
__device__ __forceinline__ TrItem expert_item(const Ctx& C, int l, int it) {
    const int e = it / 1536; int r = it % 1536; const size_t eo = (size_t)(l * NE + e) * 2048 * 512; TrItem t;
    if (r < 1024) { const int up = r >= 512; r &= 511; const int kb = r / 16, nb = r % 16, n0 = 32 * nb;
        t.W = (up ? AIN(I_WEU) : AIN(I_WEG)) + eo; t.N = 512; t.k0 = 64 * kb; t.n0 = n0; t.WT = (bf16*)(C.ws + WS_WE1 + (size_t)e * 1024 * 2048); t.K = 2048; t.drow0 = 256 * (n0 >> 7) + (n0 & 127) + (up ? 128 : 0); t.f8scale = pg8::F8_SC1; }
    else { r -= 1024; const int kb = r / 64, nb = r % 64;
        t.W = AIN(I_WED) + eo; t.N = 2048; t.k0 = 64 * kb; t.n0 = 32 * nb; t.WT = (bf16*)(C.ws + WS_WE2 + (size_t)e * 2048 * 512); t.K = 512; t.drow0 = 32 * nb; t.f8scale = pg8::F8_SC2; }
    return t;
}
#define CONV_PASS(NITEMS, DECODE) do { \
        const int nmod_ = skew ? min(C.G, DEPTH * 96) : 0, nsl_ = skew ? ((int)blockIdx.x < nmod_ ? 3 : 4) : 1, TS_ = skew ? nmod_ * NWAVES * 3 + (C.G - nmod_) * NWAVES * 4 : C.NGW; \
        const int sb_ = skew ? ((int)blockIdx.x < nmod_ ? C.gw * 3 : nmod_ * NWAVES * 3 + (C.gw - nmod_ * NWAVES) * 4) : C.gw; \
        int k_ = 0, it_ = sb_; f32x4 va_[8], vb_[8]; TrItem ta_, tb_; \
        if (it_ < (NITEMS)) { ta_ = DECODE(it_); tr_load(ta_, va_, C.lane); } \
        while (it_ < (NITEMS)) { ++k_; const int in_ = sb_ + (k_ % nsl_) + (k_ / nsl_) * TS_; \
            if (in_ < (NITEMS)) { tb_ = DECODE(in_); tr_load(tb_, vb_, C.lane); } \
            __builtin_amdgcn_sched_barrier(0); \
            tr_store(ta_, va_, scr, C.lane); \
            _Pragma("unroll") for (int i_ = 0; i_ < 8; ++i_) va_[i_] = vb_[i_]; ta_ = tb_; it_ = in_; \
            __builtin_amdgcn_sched_barrier(0); } } while (0)
__device__ __forceinline__ void ph_conv_dense_w(const Args& a, const Ctx& C) {
    LAS float* scr = (LAS float*)(C.lds + RING_OFF + C.wave * CONV_SCR); const bool skew = true;
#define DEC_DENSE(i) dense_item(C, (i))
    CONV_PASS(DEPTH * (32 * 208 + 32 * 64), DEC_DENSE);
#undef DEC_DENSE
}
__device__ __forceinline__ void ph_conv_expert_w(const Args& a, const Ctx& C, int l, bool skew) {
    LAS float* scr = (LAS float*)(C.lds + RING_OFF + C.wave * CONV_SCR);
#define DEC_EXP(i) expert_item(C, l, (i))
    CONV_PASS(NE * 1536, DEC_EXP);
#undef DEC_EXP
}
#undef CONV_PASS

constexpr int TBL_OFF = RING_OFF + NWAVES * CONV_SCR;
static_assert(TBL_OFF + 6 * 8192 <= RING_OFF + RING_BYTES, "LDS tables");
__device__ __forceinline__ int stream_nslots(const Ctx& C) { const int wpb = C.G >> 2, rpw = (SEQ_T + wpb - 1) / wpb; return (rpw + NWAVES - 1) / NWAVES + (MC + C.NGW - 1) / C.NGW; }
__device__ __forceinline__ int stream_row(const Ctx& C, int k, int nrows) {
    const int wpb = C.G >> 2, rpw = (SEQ_T + wpb - 1) / wpb, nl = (rpw + NWAVES - 1) / NWAVES, b = (int)blockIdx.x / wpb, wi = (int)blockIdx.x % wpb;
    if (k < nl) { const int q = C.wave + NWAVES * k, t = wi * rpw + q; return (b < NB && q < rpw && t < SEQ_T) ? b * SEQ_T + t : -1; }
    const int c = (k - nl) * C.NGW + C.wave * C.G + (int)blockIdx.x; return (c < MC && ML + c < nrows) ? ML + c : -1;
}
__device__ __forceinline__ int stream_batch(const Ctx& C) { const int b = (int)blockIdx.x / (C.G >> 2); return b < NB ? b : NB - 1; }

__device__ __forceinline__ void ph_norm1_tables(const Ctx& C, int l) {
    LAS float* T = (LAS float*)(C.lds + TBL_OFF); const float* gmix = AIN(I_GMIX) + (size_t)l * D; const int rb = stream_batch(C);
    for (int i = C.tid; i < 2 * 2048; i += NTHREADS) { const int set = i >> 11, col = i & 2047, r = set ? 4 : rb;
        T[(set * 3 + 0) * 2048 + col] = gmix[col] * (1.f + modp(C, l, r, 1)[col]); T[(set * 3 + 1) * 2048 + col] = modp(C, l, r, 0)[col];
        T[(set * 3 + 2) * 2048 + col] = l > 0 ? modp(C, l - 1, r, 5)[col] * (1.f / pg8::F8_SCY) : 0.f; }
}
__device__ __forceinline__ void ph_norm1(const Args& a, const Ctx& C, int l) {
    float* XL = (float*)(C.ws + WS_XL); bf16* H = (bf16*)(C.ws + WS_H); const unsigned char* Y = (const unsigned char*)(C.ws + WS_Y);
    const LAS float* T = (const LAS float*)(C.lds + TBL_OFF);
    f32x4 va[8], vb[8]; int pa[8], qa[8], pb[8], qb[8];
#pragma unroll
    for (int j = 0; j < 8; ++j) { pa[j] = 0; qa[j] = 0; pb[j] = 0; qb[j] = 0; }
#define N1_LOAD(V, P, Q, rw) do { const int rw_ = (rw); \
        const float* src_ = (l == 0) ? (rw_ < ML ? AIN(I_X) + (size_t)rw_ * D : AIN(I_CTX) + (size_t)(rw_ - ML) * D) : XL + (size_t)rw_ * D; \
        _Pragma("unroll") for (int j = 0; j < 8; ++j) V[j] = *(const f32x4*)(src_ + C.lane * 4 + 256 * j); \
        if (l > 0) { const unsigned char* y0_ = Y + (size_t)(2 * rw_) * D; \
            _Pragma("unroll") for (int j = 0; j < 8; ++j) { P[j] = *(const int*)(y0_ + C.lane * 4 + 256 * j); Q[j] = *(const int*)(y0_ + D + C.lane * 4 + 256 * j); } } } while (0)
    const int NK = stream_nslots(C);
    int rowa = stream_row(C, 0, MT);
    if (rowa >= 0) N1_LOAD(va, pa, qa, rowa);
    for (int k = 0; k < NK; ++k) {
        const int rowb = k + 1 < NK ? stream_row(C, k + 1, MT) : -1;
        if (rowb >= 0) N1_LOAD(vb, pb, qb, rowb);
        __builtin_amdgcn_sched_barrier(0);
        if (rowa >= 0) {
            const LAS float* Ts = T + (rowa < ML ? 0 : 3 * 2048) + C.lane * 4;
            if (l > 0) {
#pragma unroll
                for (int j = 0; j < 8; ++j) { const f32x4 g = *(const LAS f32x4*)(Ts + 2 * 2048 + 256 * j);
                    va[j] = va[j] + g * (un4_fp8(pa[j]) + un4_fp8(qa[j]));
                    *(f32x4*)(XL + (size_t)rowa * D + C.lane * 4 + 256 * j) = va[j]; }
            }
            float ss = 0.f;
#pragma unroll
            for (int j = 0; j < 8; ++j) ss += (va[j].x * va[j].x + va[j].y * va[j].y) + (va[j].z * va[j].z + va[j].w * va[j].w);
            const float rs = rsqrtf(wave_sum(ss) * (1.f / D) + EPS);
#pragma unroll
            for (int j = 0; j < 8; ++j) { const f32x4 ga = *(const LAS f32x4*)(Ts + 256 * j), sh = *(const LAS f32x4*)(Ts + 2048 + 256 * j);
                const f32x4 h = va[j] * rs * ga + sh; v2u o; o.x = pk2(h.x, h.y); o.y = pk2(h.z, h.w); *(v2u*)(H + (size_t)rowa * D + C.lane * 4 + 256 * j) = o; }
        }
#pragma unroll
        for (int j = 0; j < 8; ++j) { va[j] = vb[j]; pa[j] = pb[j]; qa[j] = qb[j]; }
        rowa = rowb;
        __builtin_amdgcn_sched_barrier(0);
    }
#undef N1_LOAD
}

constexpr size_t WS_UST = WS_Y;
constexpr size_t WS_QB = WS_H;
constexpr size_t WS_UD = WS_H + 34 * MiB;
constexpr int HG_UNITS = 32 * 68;
__device__ __forceinline__ float hgrn_lb(const Ctx& C, int l, int dir, int idx) {
    if (l == 0) return 0.f;
    const float* hl = AIN(I_HLB); const float a0 = hl[(0 * 2 + dir) * 512 + idx], a1 = hl[(1 * 2 + dir) * 512 + idx]; return 1.f / (1.f + __expf(a0 - a1));
}
__device__ __forceinline__ void ph_hgrn_a(const Args& a, const Ctx& C, int l) {
    const bf16* U = (const bf16*)(C.ws + WS_U); const bf16* VT = (const bf16*)(C.ws + WS_VT); bf16* HGO = (bf16*)(C.ws + WS_HGO);
    bf16* UST = (bf16*)(C.ws + WS_UST); bf16* QB = (bf16*)(C.ws + WS_QB); float* UD = (float*)(C.ws + WS_UD);
    constexpr int QS = 272, KS = 144;
    LAS unsigned char* Qt = C.lds + RING_OFF; LAS unsigned char* Kt = Qt + 64 * QS; LAS unsigned char* KbT = Kt + 64 * QS; LAS float* tot = (LAS float*)(KbT + 128 * KS);
    LAS unsigned char* Qbl = (LAS unsigned char*)(tot + 512);
    const int tid = C.tid, k = tid & 127, seg = tid >> 7, w = C.wave, j16 = C.lane & 15, g = C.lane >> 4;
    const int lr = tid >> 4, lc = (tid & 15) * 8;
    v4u rz0, rz1, rq0, rq1;
#define HG_LOADRAW(un) do { const int seq_ = (un) / 68, mc_ = (un) % 68, b_ = seq_ >> 3, h_ = (seq_ >> 1) & 3, dir_ = seq_ & 1; \
        const int tb_ = mc_ < 4 ? ML + b_ * CTX_L + 64 * mc_ : b_ * SEQ_T + 64 * (mc_ - 4); const int zo_ = dir_ ? OFF_HB : OFF_HF; \
        const bf16* ub_ = U + (size_t)tb_ * IN_DIM + h_ * 128 + lc; \
        rz0 = *(const v4u*)(ub_ + (size_t)lr * IN_DIM + zo_); rz1 = *(const v4u*)(ub_ + (size_t)(lr + 32) * IN_DIM + zo_); \
        rq0 = *(const v4u*)(ub_ + (size_t)lr * IN_DIM + OFF_HQ); rq1 = *(const v4u*)(ub_ + (size_t)(lr + 32) * IN_DIM + OFF_HQ); } while (0)
    if ((int)blockIdx.x < HG_UNITS) HG_LOADRAW(blockIdx.x);
    for (int unit = blockIdx.x; unit < HG_UNITS; unit += C.G) {
        const int seq = unit / 68, mc = unit % 68, b = seq >> 3, h = (seq >> 1) & 3, dir = seq & 1;
        const int tokbase = mc < 4 ? ML + b * CTX_L + 64 * mc : b * SEQ_T + 64 * (mc - 4);
        const float lb = hgrn_lb(C, l, dir, h * 128 + k);
        const int tq = w & 3, vh = w >> 2, pq = 16 * tq + j16;
        const bf16* vrow = VT + (size_t)(1024 + h * 128 + j16) * MT + tokbase + 8 * g;
        bf16x8 vu[8][2];
#pragma unroll
        for (int vt = 0; vt < 8; ++vt) { vu[vt][0] = *(const bf16x8*)(vrow + (size_t)(16 * vt) * MT); vu[vt][1] = *(const bf16x8*)(vrow + (size_t)(16 * vt) * MT + 32); }
        *(LAS v4u*)(Kt + lr * QS + 2 * lc) = rz0; *(LAS v4u*)(Kt + (lr + 32) * QS + 2 * lc) = rz1; *(LAS v4u*)(Qt + lr * QS + 2 * lc) = rq0; *(LAS v4u*)(Qt + (lr + 32) * QS + 2 * lc) = rq1;
        __syncthreads();
        float cs[16], sq[16], kk[16]; float run = 0.f;
        const int pstep = dir ? -QS : QS, pa0 = (dir ? 63 - 16 * seg : 16 * seg) * QS + 2 * k;
#pragma unroll
        for (int i = 0; i < 16; ++i) { const int po = pa0 + i * pstep;
            const float zv = bf2f(*(const LAS unsigned short*)(Kt + po)), qv = bf2f(*(const LAS unsigned short*)(Qt + po));
            const float f = lb + (1.f - lb) * sigm(zv); run += __builtin_amdgcn_logf(f);     cs[i] = run; kk[i] = 1.f - f; sq[i] = silu(qv); }
        tot[seg * 128 + k] = run;
        __syncthreads();
        const float t0 = tot[k], t1 = tot[128 + k], t2 = tot[256 + k], t3 = tot[384 + k];
        const float off = (seg > 0 ? t0 : 0.f) + (seg > 1 ? t1 : 0.f) + (seg > 2 ? t2 : 0.f), bmid = t0 + t1, blast = (t0 + t1) + (t2 + t3);
        const float ebm = __builtin_amdgcn_exp2f(bmid), elm = __builtin_amdgcn_exp2f(blast - bmid);
        float kb[16];
#pragma unroll
        for (int i = 0; i < 16; ++i) { const int po = pa0 + i * pstep; const float bb = off + cs[i];
            const float qt = sq[i] * __builtin_amdgcn_exp2f(fminf(bb - bmid, 115.f)), kt = kk[i] * __builtin_amdgcn_exp2f(fminf(bmid - bb, 115.f));
            const unsigned qq = pk2(qt, qt * ebm), kq = pk2(kt, kt);
            *(LAS unsigned short*)(Qt + po) = (unsigned short)qq; *(LAS unsigned short*)(Kt + po) = (unsigned short)kq;
            *(LAS unsigned short*)(Qbl + po) = (unsigned short)(qq >> 16); kb[i] = kt * elm; }
        {
            v4u w0, w1;
            if (!dir) { w0.x = pk2(kb[0], kb[1]); w0.y = pk2(kb[2], kb[3]); w0.z = pk2(kb[4], kb[5]); w0.w = pk2(kb[6], kb[7]); w1.x = pk2(kb[8], kb[9]); w1.y = pk2(kb[10], kb[11]); w1.z = pk2(kb[12], kb[13]); w1.w = pk2(kb[14], kb[15]); }
            else { w0.x = pk2(kb[15], kb[14]); w0.y = pk2(kb[13], kb[12]); w0.z = pk2(kb[11], kb[10]); w0.w = pk2(kb[9], kb[8]); w1.x = pk2(kb[7], kb[6]); w1.y = pk2(kb[5], kb[4]); w1.z = pk2(kb[3], kb[2]); w1.w = pk2(kb[1], kb[0]); }
            const int p0 = dir ? 48 - 16 * seg : 16 * seg;
            *(LAS v4u*)(KbT + k * KS + 2 * p0) = w0; *(LAS v4u*)(KbT + k * KS + 2 * p0 + 16) = w1; }
        if (seg == 0) UD[(size_t)unit * 128 + k] = __builtin_amdgcn_exp2f(blast);
        __builtin_amdgcn_sched_barrier(0);
        __syncthreads();
        if (unit + C.G < HG_UNITS) HG_LOADRAW(unit + C.G);
        __builtin_amdgcn_sched_barrier(0);
        { bf16* qb = QB + ((size_t)dir * MT + tokbase) * 512 + h * 128 + lc;
            *(v4u*)(qb + (size_t)lr * 512) = *(const LAS v4u*)(Qbl + lr * QS + 2 * lc); *(v4u*)(qb + (size_t)(lr + 32) * 512) = *(const LAS v4u*)(Qbl + (lr + 32) * QS + 2 * lc); }
        { bf16x8 pf[2];
#pragma unroll
            for (int sg = 0; sg < 2; ++sg) { f32x4 a0 = {0.f, 0.f, 0.f, 0.f}, a1 = {0.f, 0.f, 0.f, 0.f};
                const int prow = 32 * sg + 8 * (j16 >> 2) + (j16 & 3);
#pragma unroll
                for (int ks = 0; ks < 4; ++ks) { const bf16x8 kf0 = *(const LAS bf16x8*)(Kt + prow * QS + 2 * (32 * ks + 8 * g)), kf1 = *(const LAS bf16x8*)(Kt + (prow + 4) * QS + 2 * (32 * ks + 8 * g));
                    const bf16x8 qf = *(const LAS bf16x8*)(Qt + pq * QS + 2 * (32 * ks + 8 * g));
                    a0 = __builtin_amdgcn_mfma_f32_16x16x32_bf16(kf0, qf, a0, 0, 0, 0); a1 = __builtin_amdgcn_mfma_f32_16x16x32_bf16(kf1, qf, a1, 0, 0, 0); }
#pragma unroll
                for (int t = 0; t < 4; ++t) { const int pk0 = 32 * sg + 8 * g + t, pk1 = pk0 + 4;
                    const bool ok0 = dir ? (pk0 >= pq) : (pk0 <= pq), ok1 = dir ? (pk1 >= pq) : (pk1 <= pq); a0[t] = ok0 ? a0[t] : 0.f; a1[t] = ok1 ? a1[t] : 0.f; }
                v4u pw; pw.x = pg8::cvt_pk_bf16(a0[0], a0[1]); pw.y = pg8::cvt_pk_bf16(a0[2], a0[3]); pw.z = pg8::cvt_pk_bf16(a1[0], a1[1]); pw.w = pg8::cvt_pk_bf16(a1[2], a1[3]);
                pf[sg] = __builtin_bit_cast(bf16x8, pw); }
#pragma unroll
            for (int vi = 0; vi < 4; ++vi) { const int vt = 4 * vh + vi; f32x4 o = {0.f, 0.f, 0.f, 0.f};
                const bf16x8 v0 = vh ? vu[4 + vi][0] : vu[vi][0], v1 = vh ? vu[4 + vi][1] : vu[vi][1];
                o = __builtin_amdgcn_mfma_f32_16x16x32_bf16(v0, pf[0], o, 0, 0, 0); o = __builtin_amdgcn_mfma_f32_16x16x32_bf16(v1, pf[1], o, 0, 0, 0);
                v2u ow; ow.x = pg8::cvt_pk_bf16(o[0], o[1]); ow.y = pg8::cvt_pk_bf16(o[2], o[3]); *(v2u*)(HGO + ((size_t)dir * MT + tokbase + pq) * 512 + h * 128 + 16 * vt + 4 * g) = ow; }
        }
        { const bf16x8 kb0 = *(const LAS bf16x8*)(KbT + (16 * w + j16) * KS + 2 * (8 * g)), kb1 = *(const LAS bf16x8*)(KbT + (16 * w + j16) * KS + 2 * (32 + 8 * g));
#pragma unroll
            for (int vt = 0; vt < 8; ++vt) { f32x4 u = {0.f, 0.f, 0.f, 0.f};
                u = __builtin_amdgcn_mfma_f32_16x16x32_bf16(kb0, vu[vt][0], u, 0, 0, 0); u = __builtin_amdgcn_mfma_f32_16x16x32_bf16(kb1, vu[vt][1], u, 0, 0, 0);
                v2u uw; uw.x = pg8::cvt_pk_bf16(u[0], u[1]); uw.y = pg8::cvt_pk_bf16(u[2], u[3]); *(v2u*)(UST + ((size_t)unit * 128 + 16 * vt + j16) * 128 + 16 * w + 4 * g) = uw; }
        }
        __syncthreads();
    }
#undef HG_LOADRAW
}
__device__ __forceinline__ void ph_hgrn_scan(const Ctx& C) {
    const bf16* UST = (const bf16*)(C.ws + WS_UST); const float* UD = (const float*)(C.ws + WS_UD); bf16* SST = (bf16*)(C.ws + WS_SSTATE);
    for (int e = C.gw * 64 + C.lane; e < 32 * 4096; e += C.NGW * 64) {
        const int seq = e >> 12, vk = e & 4095, v = vk >> 5, k4 = (vk & 31) * 4, dir = seq & 1;
        f32x4 S = {0.f, 0.f, 0.f, 0.f}, da[4], db[4]; v2u ua[4], ub[4];
#define HG_MC(step) (dir ? ((step) < 4 ? 3 - (step) : 71 - (step)) : (step))
#pragma unroll
        for (int i = 0; i < 4; ++i) { const size_t unit = (size_t)seq * 68 + HG_MC(i); ua[i] = *(const v2u*)(UST + (unit * 128 + v) * 128 + k4); da[i] = *(const f32x4*)(UD + unit * 128 + k4); }
        for (int bi = 0; bi < 17; ++bi) {
            const int nb = bi + 1 < 17 ? bi + 1 : bi;
#pragma unroll
            for (int i = 0; i < 4; ++i) { const size_t unit = (size_t)seq * 68 + HG_MC(4 * nb + i); ub[i] = *(const v2u*)(UST + (unit * 128 + v) * 128 + k4); db[i] = *(const f32x4*)(UD + unit * 128 + k4); }
            __builtin_amdgcn_sched_barrier(0);
#pragma unroll
            for (int i = 0; i < 4; ++i) { const size_t unit = (size_t)seq * 68 + HG_MC(4 * bi + i);
                v2u w; w.x = pk2(S.x, S.y); w.y = pk2(S.z, S.w); *(v2u*)(SST + (unit * 128 + v) * 128 + k4) = w;
                const f32x4 uf = {bflo(ua[i].x), bfhi(ua[i].x), bflo(ua[i].y), bfhi(ua[i].y)}; S = da[i] * S + uf; }
#pragma unroll
            for (int i = 0; i < 4; ++i) { ua[i] = ub[i]; da[i] = db[i]; }
            __builtin_amdgcn_sched_barrier(0);
        }
#undef HG_MC
    }
}
constexpr int RO_RED_OFF = LDSCTL_OFF + 4096;
__device__ __forceinline__ void ph_hgrn_readout(const Args& a, const Ctx& C, int l, bool last) {
    const bf16* U = (const bf16*)(C.ws + WS_U); const bf16* HGO = (const bf16*)(C.ws + WS_HGO); unsigned char* CAT = (unsigned char*)(C.ws + WS_CAT);
    const bf16* SST = (const bf16*)(C.ws + WS_SSTATE); const bf16* QB = (const bf16*)(C.ws + WS_QB);
    const float* ng = AIN(I_HNG) + (size_t)l * 512;
    const int j16 = C.lane & 15, g = C.lane >> 4, tq = C.wave & 3, vh = C.wave >> 2;
    const int nch = last ? 16 * 64 : 16 * 68;
    LAS unsigned char* ring = C.lds + RING_OFF; LAS float* red = (LAS float*)(C.lds + RO_RED_OFF);
#define RO_DEC(ch, bh_, mc_) const int bh_ = last ? (ch) >> 6 : (ch) / 68, mc_ = last ? 4 + ((ch) & 63) : (ch) % 68
#define RO_DMA(ch, buf) do { RO_DEC(ch, bh_, mc_); _Pragma("unroll") for (int dir = 0; dir < 2; ++dir) { const bf16* src_ = SST + ((size_t)(bh_ * 2 + dir) * 68 + mc_) * 16384; \
        _Pragma("unroll") for (int i = 0; i < 4; ++i) { const int I_ = C.wave * 4 + i, row_ = 4 * I_ + g, ck_ = j16 ^ (row_ & 15); \
            __builtin_amdgcn_global_load_lds((const unsigned*)(src_ + row_ * 128 + ck_ * 8), (LAS unsigned*)(ring + (buf) * 65536 + dir * 32768 + I_ * 1024), 16, 0, 0); } } } while (0)
#define RO_REGS(ch, QF, HF, HB, GR, NN, TOK) do { RO_DEC(ch, bh_, mc_); const int b_ = bh_ >> 2, h_ = bh_ & 3; TOK = (mc_ < 4 ? ML + b_ * CTX_L + 64 * mc_ : b_ * SEQ_T + 64 * (mc_ - 4)) + 16 * tq + j16; \
        _Pragma("unroll") for (int dir = 0; dir < 2; ++dir) { const bf16* qp_ = QB + ((size_t)dir * MT + TOK) * 512 + h_ * 128 + 8 * g; _Pragma("unroll") for (int ks = 0; ks < 4; ++ks) QF[dir][ks] = *(const bf16x8*)(qp_ + 32 * ks); } \
        _Pragma("unroll") for (int vi = 0; vi < 4; ++vi) { const int co_ = h_ * 128 + 16 * (4 * vh + vi) + 4 * g; HF[vi] = *(const v2u*)(HGO + (size_t)TOK * 512 + co_); HB[vi] = *(const v2u*)(HGO + ((size_t)MT + TOK) * 512 + co_); \
            GR[vi] = *(const v2u*)(U + (size_t)TOK * IN_DIM + OFF_HG + co_); NN[vi] = *(const f32x4*)(ng + co_); } } while (0)
    bf16x8 qa[2][4], qb[2][4]; v2u hfa[4], hba[4], gra[4], hfb[4], hbb[4], grb[4]; f32x4 nna[4], nnb[4]; int toka = 0, tokb = 0;
    int ch = blockIdx.x, cur = 0;
    if (ch < nch) { RO_REGS(ch, qa, hfa, hba, gra, nna, toka); RO_DMA(ch, 0); }
    for (; ch < nch; ch += C.G) {
        const int nx = ch + C.G;
        if (nx < nch) { RO_REGS(nx, qb, hfb, hbb, grb, nnb, tokb); RO_DMA(nx, cur ^ 1); asm volatile("s_waitcnt vmcnt(32)" ::: "memory"); }
        else asm volatile("s_waitcnt vmcnt(0)" ::: "memory");
        __syncthreads();
        f32x4 acc[4];
#pragma unroll
        for (int vi = 0; vi < 4; ++vi) acc[vi] = (f32x4){bflo(hfa[vi].x) + bflo(hba[vi].x), bfhi(hfa[vi].x) + bfhi(hba[vi].x), bflo(hfa[vi].y) + bflo(hba[vi].y), bfhi(hfa[vi].y) + bfhi(hba[vi].y)};
        const LAS unsigned char* st = ring + cur * 65536 + (64 * vh + j16) * 256;
#pragma unroll
        for (int dir = 0; dir < 2; ++dir)
#pragma unroll
            for (int vi = 0; vi < 4; ++vi)
#pragma unroll
                for (int ks = 0; ks < 4; ++ks)
                    acc[vi] = __builtin_amdgcn_mfma_f32_16x16x32_bf16(*(const LAS bf16x8*)(st + dir * 32768 + vi * 4096 + (((4 * ks + g) ^ j16) << 4)), qa[dir][ks], acc[vi], 0, 0, 0);
        float ss = 0.f;
#pragma unroll
        for (int vi = 0; vi < 4; ++vi) ss += (acc[vi][0] * acc[vi][0] + acc[vi][1] * acc[vi][1]) + (acc[vi][2] * acc[vi][2] + acc[vi][3] * acc[vi][3]);
        ss += __shfl_xor(ss, 16); ss += __shfl_xor(ss, 32);
        if (g == 0) red[C.wave * 16 + j16] = ss;
        __syncthreads();
        const float s0 = red[tq * 16 + j16], s1 = red[(4 + tq) * 16 + j16];
        const float rs = rsqrtf((s0 + s1) * (1.f / 128.f) + EPS);
        { RO_DEC(ch, bh_, mc_); const int h_ = bh_ & 3; (void)mc_;
            unsigned char* op = CAT + (size_t)toka * D + 1536 + h_ * 128 + 16 * (4 * vh) + 4 * g;
#pragma unroll
            for (int vi = 0; vi < 4; ++vi) {
                const float r0 = acc[vi][0] * rs * nna[vi].x * silu(bflo(gra[vi].x)), r1 = acc[vi][1] * rs * nna[vi].y * silu(bfhi(gra[vi].x)), r2 = acc[vi][2] * rs * nna[vi].z * silu(bflo(gra[vi].y)), r3 = acc[vi][3] * rs * nna[vi].w * silu(bfhi(gra[vi].y));
                *(unsigned*)(op + 16 * vi) = pg8::cvt4_fp8(r0, r1, r2, r3); } }
#pragma unroll
        for (int dir = 0; dir < 2; ++dir)
#pragma unroll
            for (int ks = 0; ks < 4; ++ks) qa[dir][ks] = qb[dir][ks];
#pragma unroll
        for (int vi = 0; vi < 4; ++vi) { hfa[vi] = hfb[vi]; hba[vi] = hbb[vi]; gra[vi] = grb[vi]; nna[vi] = nnb[vi]; }
        toka = tokb; cur ^= 1;
    }
#undef RO_DEC
#undef RO_DMA
#undef RO_REGS
}
constexpr int CONVW_LDS = 57344;
__device__ __forceinline__ void conv_stage_w(const Args& a, const Ctx& C, int l) {
    const float* cw = AIN(I_CONVW) + (size_t)l * 31 * 512; LAS float* wl = (LAS float*)(C.lds + RING_OFF + CONVW_LDS);
    for (int i = C.tid * 4; i < 31 * 512; i += NTHREADS * 4) *(LAS f32x4*)(wl + i) = *(const f32x4*)(cw + i);
}
template <int R> __device__ __forceinline__ void conv_block(const Ctx& C, const bf16* U, unsigned char* CAT, const LAS float* wl, const float* cb, const float* lg, const float* lbb, int row0, int t0, int len) {
    constexpr int NI = R + 30;
    int ln_ = C.lane; asm volatile("" : "+v"(ln_));
    const int ch0 = ln_ * 8, seqbase = row0 - t0;
    v4u h[NI];
#pragma unroll
    for (int i = 0; i < NI; ++i) { const int tt = t0 - 15 + i; const unsigned long long in_ = (unsigned long long)(0ll - (long long)((unsigned)tt < (unsigned)len));
        const unsigned char* rp = C.ws + ((WS_U + (unsigned long long)(unsigned)(seqbase + tt) * (IN_DIM * 2)) & in_); h[i] = *(const v4u*)(rp + ch0 * 2); }
    __builtin_amdgcn_sched_barrier(0);
    float acc[R][8];
    { const f32x4 b0 = *(const f32x4*)(cb + ch0), b1 = *(const f32x4*)(cb + ch0 + 4);
#pragma unroll
        for (int r = 0; r < R; ++r) { acc[r][0] = b0.x; acc[r][1] = b0.y; acc[r][2] = b0.z; acc[r][3] = b0.w; acc[r][4] = b1.x; acc[r][5] = b1.y; acc[r][6] = b1.z; acc[r][7] = b1.w; } }
#pragma unroll
    for (int j = 0; j < 31; ++j) {
        const f32x4 w0 = *(const LAS f32x4*)(wl + j * 512 + ch0), w1 = *(const LAS f32x4*)(wl + j * 512 + ch0 + 4);
#pragma unroll
        for (int r = 0; r < R; ++r) { const v4u hv = h[r + j];
            acc[r][0] += w0.x * bflo(hv.x); acc[r][1] += w0.y * bfhi(hv.x); acc[r][2] += w0.z * bflo(hv.y); acc[r][3] += w0.w * bfhi(hv.y);
            acc[r][4] += w1.x * bflo(hv.z); acc[r][5] += w1.y * bfhi(hv.z); acc[r][6] += w1.z * bflo(hv.w); acc[r][7] += w1.w * bfhi(hv.w); }
        if ((j & 3) == 3) {
#pragma unroll
            for (int r = 0; r < R; ++r) asm volatile("" : "+v"(acc[r][0]), "+v"(acc[r][1]), "+v"(acc[r][2]), "+v"(acc[r][3]), "+v"(acc[r][4]), "+v"(acc[r][5]), "+v"(acc[r][6]), "+v"(acc[r][7]) :: "memory");
            __builtin_amdgcn_sched_barrier(0); }
    }
    const f32x4 g0 = *(const f32x4*)(lg + ch0), g1 = *(const f32x4*)(lg + ch0 + 4), c0 = *(const f32x4*)(lbb + ch0), c1 = *(const f32x4*)(lbb + ch0 + 4);
    const float gg[8] = {g0.x, g0.y, g0.z, g0.w, g1.x, g1.y, g1.z, g1.w}, bb[8] = {c0.x, c0.y, c0.z, c0.w, c1.x, c1.y, c1.z, c1.w};
#pragma unroll
    for (int r = 0; r < R; ++r) {
        float sm = 0.f;
#pragma unroll
        for (int i = 0; i < 8; ++i) sm += acc[r][i];
        const float mean = wave_sum(sm) * (1.f / 512.f); float qq = 0.f;
#pragma unroll
        for (int i = 0; i < 8; ++i) { acc[r][i] -= mean; qq += acc[r][i] * acc[r][i]; }
        const float rs = rsqrtf(wave_sum(qq) * (1.f / 512.f) + EPS);
        float o[8];
#pragma unroll
        for (int i = 0; i < 8; ++i) o[i] = silu(acc[r][i] * rs * gg[i] + bb[i]);
        v2u w; w.x = pg8::cvt4_fp8(o[0], o[1], o[2], o[3]); w.y = pg8::cvt4_fp8(o[4], o[5], o[6], o[7]);
        *(v2u*)(CAT + (size_t)(row0 + r) * D + ch0) = w;
    }
}
__device__ __forceinline__ void ph_conv(const Args& a, const Ctx& C, int l, int nrows) {
    const bf16* U = (const bf16*)(C.ws + WS_U); unsigned char* CAT = (unsigned char*)(C.ws + WS_CAT);
    const float* cb = AIN(I_CONVB) + (size_t)l * 512; const float* lg = AIN(I_CLNG) + (size_t)l * 512; const float* lbb = AIN(I_CLNB) + (size_t)l * 512;
    const LAS float* wl = (const LAS float*)(C.lds + RING_OFF + CONVW_LDS);
    for (int blk = C.gw; blk < ML / 4; blk += C.NGW) { const int row0 = 4 * blk; conv_block<4>(C, U, CAT, wl, cb, lg, lbb, row0, row0 & (SEQ_T - 1), SEQ_T); }
    for (int row = ML + C.wave * C.G + (int)blockIdx.x; row < nrows; row += C.NGW) conv_block<1>(C, U, CAT, wl, cb, lg, lbb, row, (row - ML) & (CTX_L - 1), CTX_L);
}
template <bool WIN> __device__ __forceinline__ void ph_attn(const Args& a, const Ctx& C, int l, int gw, int ngw) {
    const bf16* U = (const bf16*)(C.ws + WS_U); const bf16* VT = (const bf16*)(C.ws + WS_VT); bf16* CAT = (bf16*)(C.ws + WS_CAT);
    constexpr int NG = WIN ? 16 : 8, GW = WIN ? 8 : 0, NB2 = NG / 2;
    const int nunits = WIN ? NB * 16 * 64 * 4 : NB * 16 * 16;
    const int q = C.lane & 15, g = C.lane >> 4;
    LAS float* rl = (LAS float*)(C.lds + RING_OFF) + C.wave * 512;
    const int xcd = blockIdx.x & 7, nlu = nunits / 8;
    for (int lu = gw; lu < nlu; lu += ngw) {
        int b, h, r = 0, j, tokq;
        if (WIN) { const int pair = xcd * 8 + (lu >> 8); j = lu & 3; r = (lu >> 2) & 63; h = pair & 15; b = pair >> 4; tokq = b * SEQ_T + r * 64 + 16 * j + q; }
        else { const int pair = xcd * 8 + (lu >> 4); j = lu & 15; h = pair & 15; b = pair >> 4; tokq = ML + b * CTX_L + 16 * j + q; }
        const int sr = min(max(r - 4, 0), 56), kstart = min(max(16 * j - 8, 0), 32);
        const int c = 16 * j + q, wsq = min(max(c - 8, 0), 48);
        if (WIN) { const float* rpb = AIN(I_RPB) + (size_t)(l * 16 + h) * 465; float tv[8];
#pragma unroll
            for (int i = 0; i < 8; ++i) tv[i] = rpb[min(C.lane + 64 * i, 464)];
            LDS_WAIT(); asm volatile("" ::: "memory");
#pragma unroll
            for (int i = 0; i < 8; ++i) if (C.lane + 64 * i < 465) rl[C.lane + 64 * i] = tv[i]; }
        const bf16* qp = U + (size_t)tokq * IN_DIM + OFF_Q + h * 64 + 8 * g;
        const bf16x8 qf0 = *(const bf16x8*)qp, qf1 = *(const bf16x8*)(qp + 32);
        const bf16* kbase = U + (size_t)(8 * (q >> 2) + (q & 3)) * IN_DIM + OFF_K + h * 64 + 8 * g;
#define NA_TOK0(G) ((WIN && (G) < GW) ? b * SEQ_T + (sr + (G)) * 64 + kstart : ML + b * CTX_L + 32 * ((G) - GW))
        constexpr int PD = 4;
        f32x4 s[NG][2]; bf16x8 kr[PD][4];
#pragma unroll
        for (int u = 0; u < PD; ++u) { const bf16* kp = kbase + (size_t)NA_TOK0(u) * IN_DIM;
            kr[u][0] = *(const bf16x8*)kp; kr[u][1] = *(const bf16x8*)(kp + 32); kr[u][2] = *(const bf16x8*)(kp + 4 * IN_DIM); kr[u][3] = *(const bf16x8*)(kp + 4 * IN_DIM + 32); }
        LDS_WAIT(); asm volatile("" ::: "memory");
        __builtin_amdgcn_sched_barrier(0);
#pragma unroll
        for (int G = 0; G < NG; ++G) { const int u = G % PD; const f32x4 z = {0.f, 0.f, 0.f, 0.f};
            f32x4 s0 = __builtin_amdgcn_mfma_f32_16x16x32_bf16(kr[u][0], qf0, z, 0, 0, 0); s0 = __builtin_amdgcn_mfma_f32_16x16x32_bf16(kr[u][1], qf1, s0, 0, 0, 0);
            f32x4 s1 = __builtin_amdgcn_mfma_f32_16x16x32_bf16(kr[u][2], qf0, z, 0, 0, 0); s1 = __builtin_amdgcn_mfma_f32_16x16x32_bf16(kr[u][3], qf1, s1, 0, 0, 0);
            if (G + PD < NG) { const bf16* kp = kbase + (size_t)NA_TOK0(G + PD) * IN_DIM;
                kr[u][0] = *(const bf16x8*)kp; kr[u][1] = *(const bf16x8*)(kp + 32); kr[u][2] = *(const bf16x8*)(kp + 4 * IN_DIM); kr[u][3] = *(const bf16x8*)(kp + 4 * IN_DIM + 32); }
            if (WIN && G < GW) { const LAS float* rrow = rl + (sr + G - r + 7) * 31;
#pragma unroll
                for (int t = 0; t < 4; ++t) { const int kc0 = kstart + 8 * g + t, kc1 = kc0 + 4;
                    const bool ok0 = kc0 >= wsq && kc0 < wsq + 16, ok1 = kc1 >= wsq && kc1 < wsq + 16;
                    const float b0 = rrow[min(max(kc0 - c + 15, 0), 30)], b1 = rrow[min(max(kc1 - c + 15, 0), 30)];
                    s0[t] = ok0 ? s0[t] * 0.125f + b0 : -1e30f; s1[t] = ok1 ? s1[t] * 0.125f + b1 : -1e30f; } }
            else { s0 = s0 * 0.125f; s1 = s1 * 0.125f; }
            s[G][0] = s0; s[G][1] = s1;
            __builtin_amdgcn_sched_barrier(0);
        }
        float m = -3.0e38f;
#pragma unroll
        for (int G = 0; G < NG; ++G)
#pragma unroll
            for (int t = 0; t < 4; ++t) m = fmaxf(m, fmaxf(s[G][0][t], s[G][1][t]));
        m = fmaxf(m, __shfl_xor(m, 16)); m = fmaxf(m, __shfl_xor(m, 32));
        const bf16* vbase = VT + (size_t)(h * 64 + q) * MT + 8 * g;
        bf16x8 vr[PD][4];
#pragma unroll
        for (int u = 0; u < PD; ++u)
#pragma unroll
            for (int dt = 0; dt < 4; ++dt) vr[u][dt] = *(const bf16x8*)(vbase + (size_t)(16 * dt) * MT + NA_TOK0(u));
        __builtin_amdgcn_sched_barrier(0);
        float ps = 0.f; bf16x8 pf[NG];
#pragma unroll
        for (int G = 0; G < NG; ++G) { float p[8];
#pragma unroll
            for (int t = 0; t < 4; ++t) { p[t] = __expf(s[G][0][t] - m); p[4 + t] = __expf(s[G][1][t] - m); ps += p[t] + p[4 + t]; }
            v4u w; w.x = pg8::cvt_pk_bf16(p[0], p[1]); w.y = pg8::cvt_pk_bf16(p[2], p[3]); w.z = pg8::cvt_pk_bf16(p[4], p[5]); w.w = pg8::cvt_pk_bf16(p[6], p[7]);
            pf[G] = __builtin_bit_cast(bf16x8, w); }
        ps += __shfl_xor(ps, 16); ps += __shfl_xor(ps, 32);
        const float inv = __builtin_amdgcn_rcpf(ps);
        f32x4 o[4];
#pragma unroll
        for (int dt = 0; dt < 4; ++dt) o[dt] = (f32x4){0.f, 0.f, 0.f, 0.f};
        __builtin_amdgcn_sched_barrier(0);
#pragma unroll
        for (int G = 0; G < NG; ++G) { const int u = G % PD;
#pragma unroll
            for (int dt = 0; dt < 4; ++dt) o[dt] = __builtin_amdgcn_mfma_f32_16x16x32_bf16(vr[u][dt], pf[G], o[dt], 0, 0, 0);
            if (G + PD < NG) {
#pragma unroll
                for (int dt = 0; dt < 4; ++dt) vr[u][dt] = *(const bf16x8*)(vbase + (size_t)(16 * dt) * MT + NA_TOK0(G + PD)); }
            __builtin_amdgcn_sched_barrier(0);
        }
#undef NA_TOK0
        bf16* op = CAT + (size_t)tokq * D + 512 + h * 64 + 4 * g;
#pragma unroll
        for (int dt = 0; dt < 4; ++dt) { v2u w; w.x = pg8::cvt_pk_bf16(o[dt][0] * inv, o[dt][1] * inv); w.y = pg8::cvt_pk_bf16(o[dt][2] * inv, o[dt][3] * inv); *(v2u*)(op + 16 * dt) = w; }
    }
}

template <bool WIN> __device__ __forceinline__ void ph_attn_lds(const Args& a, const Ctx& C, int l) {
    const bf16* U = (const bf16*)(C.ws + WS_U); const bf16* VT = (const bf16*)(C.ws + WS_VT); bf16* CAT = (bf16*)(C.ws + WS_CAT);
    constexpr int NG = WIN ? 16 : 8, GW = WIN ? 8 : 0;
    constexpr int KSTR = 144, VWSTR = 1168, VCSTR = 528;
    constexpr int KC_OFF = WIN ? 576 * KSTR : 0, VC_OFF = WIN ? 64 * VWSTR : 0, RL_OFF = 119808;
    LAS unsigned char* L0 = C.lds + RING_OFF; LAS float* rl = (LAS float*)(L0 + RL_OFF);
    const int w = C.wave;
    const int xcd = blockIdx.x & 7, bix = blockIdx.x >> 3, nbx = C.G >> 3;
    constexpr int NUN = WIN ? 8 * 32 : 8 * 2;
    v4u kw[9], kc[4]; float bt = 0.f; bf16x8 qf0, qf1;
#define NA_KLOAD(lu_) do { int ty_ = C.tid; asm volatile("" : "+v"(ty_)); const int pr_ = xcd * 8 + (WIN ? ((lu_) >> 5) : ((lu_) >> 1)), b_ = pr_ >> 4, h_ = pr_ & 15, rp_ = (lu_) & 31; \
        const int s0_ = min(max(2 * rp_ - 4, 0), 56), nw_ = min(9, 64 - s0_), g0_ = b_ * SEQ_T + s0_ * 64, c0_ = ML + b_ * CTX_L; \
        const int r_ = WIN ? 2 * rp_ + (w >> 2) : 0, j_ = WIN ? (w & 3) : (((lu_) & 1) * 8 + w), tq_ = WIN ? b_ * SEQ_T + r_ * 64 + 16 * j_ + (ty_ & 15) : c0_ + 16 * j_ + (ty_ & 15); \
        const bf16* qp_ = U + (size_t)tq_ * IN_DIM + OFF_Q + h_ * 64 + 8 * ((ty_ >> 4) & 3); qf0 = *(const bf16x8*)qp_; qf1 = *(const bf16x8*)(qp_ + 32); \
        if (WIN) { _Pragma("unroll") for (int i = 0; i < 9; ++i) { const int cc = ty_ + 512 * i, tl = min(cc >> 3, nw_ * 64 - 1); kw[i] = *(const v4u*)(U + (size_t)(g0_ + tl) * IN_DIM + OFF_K + h_ * 64 + (cc & 7) * 8); } \
            bt = AIN(I_RPB)[(size_t)(l * 16 + h_) * 465 + min(ty_, 464)]; } \
        _Pragma("unroll") for (int i = 0; i < 4; ++i) { const int cc = ty_ + 512 * i; kc[i] = *(const v4u*)(U + (size_t)(c0_ + (cc >> 3)) * IN_DIM + OFF_K + h_ * 64 + (cc & 7) * 8); } } while (0)
    if (bix < NUN) NA_KLOAD(bix);
    for (int lu = bix; lu < NUN; lu += nbx) {
        int tz_ = C.tid; asm volatile("" : "+v"(tz_));
        const int tid = tz_, q = tid & 15, g = (tid >> 4) & 3;
        const int pair = xcd * 8 + (WIN ? (lu >> 5) : (lu >> 1)), b = pair >> 4, h = pair & 15;
        const int rp = lu & 31, r = WIN ? 2 * rp + (w >> 2) : 0, j = WIN ? (w & 3) : ((lu & 1) * 8 + w);
        const int sr0 = min(max(2 * rp - 4, 0), 56), nwr = min(9, 64 - sr0), gtok0 = b * SEQ_T + sr0 * 64, ctok0 = ML + b * CTX_L;
        const int sr = min(max(r - 4, 0), 56), kstart = min(max(16 * j - 8, 0), 32);
        const int c = 16 * j + q, wsq = min(max(c - 8, 0), 48);
        const int tokq = WIN ? b * SEQ_T + r * 64 + c : ctok0 + c;
        v4u vw[9], vc[4];
#define NA_VLOAD() do { if (WIN) { _Pragma("unroll") for (int i = 0; i < 9; ++i) { const int cc = tid + 512 * i, d = cc / 72, ch = cc % 72; vw[i] = *(const v4u*)(VT + (size_t)(h * 64 + d) * MT + gtok0 + min(ch, nwr * 8 - 1) * 8); } } } while (0)
#define NA_VLOADC() do { _Pragma("unroll") for (int i = 0; i < 4; ++i) { const int cc = tid + 512 * i; vc[i] = *(const v4u*)(VT + (size_t)(h * 64 + (cc >> 5)) * MT + ctok0 + (cc & 31) * 8); } } while (0)
        { if (WIN) {
#pragma unroll
                for (int i = 0; i < 9; ++i) { const int cc = tid + 512 * i; if ((cc >> 3) < nwr * 64) *(LAS v4u*)(L0 + (cc >> 3) * KSTR + (cc & 7) * 16) = kw[i]; }
                if (tid < 465) rl[tid] = bt; }
#pragma unroll
            for (int i = 0; i < 4; ++i) { const int cc = tid + 512 * i; *(LAS v4u*)(L0 + KC_OFF + (cc >> 3) * KSTR + (cc & 7) * 16) = kc[i]; }
        }
        __syncthreads();
        NA_VLOAD();
        __builtin_amdgcn_sched_barrier(0);
#define NL_TOKL(G) ((WIN && (G) < GW) ? (sr + (G) - sr0) * 64 + kstart : 32 * ((G) - GW))
        const int bidx = kstart + 8 * g - c + 15; int mbits = 0;
#pragma unroll
        for (int t = 0; t < 8; ++t) { const int kc = kstart + 8 * g + t; mbits |= (kc >= wsq && kc < wsq + 16) ? (1 << t) : 0; }
        constexpr int NH = WIN ? 2 : 1;
        bf16x8 pf[NG]; float mh[NH], lh[NH];
#pragma unroll
        for (int hh = 0; hh < NH; ++hh) {
            f32x4 s[8][2];
#pragma unroll
            for (int gg = 0; gg < 8; ++gg) { const int G = 8 * hh + gg;
                const LAS unsigned char* kp = L0 + ((WIN && G < GW) ? 0 : KC_OFF) + (NL_TOKL(G) + 8 * (q >> 2) + (q & 3)) * KSTR + 16 * g;
                const bf16x8 k00 = *(const LAS bf16x8*)kp, k01 = *(const LAS bf16x8*)(kp + 64), k10 = *(const LAS bf16x8*)(kp + 4 * KSTR), k11 = *(const LAS bf16x8*)(kp + 4 * KSTR + 64);
                const f32x4 z = {0.f, 0.f, 0.f, 0.f};
                f32x4 s0 = __builtin_amdgcn_mfma_f32_16x16x32_bf16(k00, qf0, z, 0, 0, 0); s0 = __builtin_amdgcn_mfma_f32_16x16x32_bf16(k01, qf1, s0, 0, 0, 0);
                f32x4 s1 = __builtin_amdgcn_mfma_f32_16x16x32_bf16(k10, qf0, z, 0, 0, 0); s1 = __builtin_amdgcn_mfma_f32_16x16x32_bf16(k11, qf1, s1, 0, 0, 0);
                if (WIN && G < GW) { const LAS float* rrow = rl + (sr + G - r + 7) * 31 + bidx;
#pragma unroll
                    for (int t = 0; t < 4; ++t) { const int k0 = __builtin_amdgcn_sbfe(mbits, t, 1), k1 = __builtin_amdgcn_sbfe(mbits, 4 + t, 1);
                        const float b0 = __builtin_bit_cast(float, (__builtin_bit_cast(int, rrow[t]) & k0) | (0xf149f2ca & ~k0)), b1 = __builtin_bit_cast(float, (__builtin_bit_cast(int, rrow[4 + t]) & k1) | (0xf149f2ca & ~k1));
                        s0[t] = s0[t] * 0.125f + b0; s1[t] = s1[t] * 0.125f + b1; } }
                else { s0 = s0 * 0.125f; s1 = s1 * 0.125f; }
                s[gg][0] = s0; s[gg][1] = s1;
                if (gg & 1) __builtin_amdgcn_sched_barrier(0);
            }
            float m = -3.0e38f;
#pragma unroll
            for (int gg = 0; gg < 8; ++gg)
#pragma unroll
                for (int t = 0; t < 4; ++t) m = fmaxf(m, fmaxf(s[gg][0][t], s[gg][1][t]));
            m = fmaxf(m, __shfl_xor(m, 16)); m = fmaxf(m, __shfl_xor(m, 32));
            const float m2 = m * 1.44269504f;
            float ps = 0.f;
#pragma unroll
            for (int gg = 0; gg < 8; ++gg) { float p[8];
#pragma unroll
                for (int t = 0; t < 4; ++t) { p[t] = __builtin_amdgcn_exp2f(__builtin_fmaf(s[gg][0][t], 1.44269504f, -m2)); p[4 + t] = __builtin_amdgcn_exp2f(__builtin_fmaf(s[gg][1][t], 1.44269504f, -m2)); ps += p[t] + p[4 + t]; }
                v4u pw; pw.x = pk2(p[0], p[1]); pw.y = pk2(p[2], p[3]); pw.z = pk2(p[4], p[5]); pw.w = pk2(p[6], p[7]);
                pf[8 * hh + gg] = __builtin_bit_cast(bf16x8, pw); }
            ps += __shfl_xor(ps, 16); ps += __shfl_xor(ps, 32);
            mh[hh] = m; lh[hh] = ps;
            __builtin_amdgcn_sched_barrier(0);
        }
        float ah[NH]; float inv;
        { const float mm = NH == 2 ? fmaxf(mh[0], mh[NH - 1]) : mh[0]; float L = 0.f;
#pragma unroll
            for (int hh = 0; hh < NH; ++hh) { ah[hh] = __expf(mh[hh] - mm); L += lh[hh] * ah[hh]; }
            inv = __builtin_amdgcn_rcpf(L); }
        NA_VLOADC();
        __builtin_amdgcn_sched_barrier(0);
        __syncthreads();
        if (WIN) {
#pragma unroll
            for (int i = 0; i < 9; ++i) { const int cc = tid + 512 * i, d = cc / 72, ch = cc % 72; if (ch < nwr * 8) *(LAS v4u*)(L0 + d * VWSTR + ch * 16) = vw[i]; } }
#pragma unroll
        for (int i = 0; i < 4; ++i) { const int cc = tid + 512 * i; *(LAS v4u*)(L0 + VC_OFF + (cc >> 5) * VCSTR + (cc & 31) * 16) = vc[i]; }
        __syncthreads();
        { const int lun = min(lu + nbx, NUN - 1); NA_KLOAD(lun); }
        __builtin_amdgcn_sched_barrier(0);
        f32x4 oh[NH][4];
#pragma unroll
        for (int hh = 0; hh < NH; ++hh)
#pragma unroll
            for (int dt = 0; dt < 4; ++dt) oh[hh][dt] = (f32x4){0.f, 0.f, 0.f, 0.f};
#pragma unroll
        for (int G = 0; G < NG; ++G) {
            const LAS unsigned char* vp = (WIN && G < GW) ? L0 + q * VWSTR + (NL_TOKL(G) + 8 * g) * 2 : L0 + VC_OFF + q * VCSTR + (NL_TOKL(G) + 8 * g) * 2;
            const int dstr = (WIN && G < GW) ? 16 * VWSTR : 16 * VCSTR;
#pragma unroll
            for (int dt = 0; dt < 4; ++dt) oh[G / 8][dt] = __builtin_amdgcn_mfma_f32_16x16x32_bf16(*(const LAS bf16x8*)(vp + dt * dstr), pf[G], oh[G / 8][dt], 0, 0, 0);
            if (G & 1) __builtin_amdgcn_sched_barrier(0);
        }
        f32x4 o[4];
#pragma unroll
        for (int dt = 0; dt < 4; ++dt) { o[dt] = oh[0][dt] * ah[0]; if (NH == 2) o[dt] = o[dt] + oh[NH - 1][dt] * ah[NH - 1]; }
#undef NL_TOKL
#undef NA_VLOAD
#undef NA_VLOADC
#undef NA_KLOAD
        unsigned char* op = (unsigned char*)CAT + (size_t)tokq * D + 512 + h * 64 + 4 * g; const float invs = inv * CAT_NA_SC;
#pragma unroll
        for (int dt = 0; dt < 4; ++dt) *(unsigned*)(op + 16 * dt) = pg8::cvt4_fp8(o[dt][0] * invs, o[dt][1] * invs, o[dt][2] * invs, o[dt][3] * invs);
        __syncthreads();
    }
}

constexpr int RW_ELEMS = 5 * 48 * 2048;
__device__ __forceinline__ void ph_router_prep(const Args& a, const Ctx& C, int l) {
    float* RW = (float*)(C.ws + WS_RW); float* RC = RW + RW_ELEMS; float* RG = RC + 256;
    const float* gffn = AIN(I_GFFN) + (size_t)l * D; const float* wrg = AIN(I_WRG) + (size_t)l * D * 4; const float* wre = AIN(I_WRE) + (size_t)l * D * 32;
    for (int idx = blockIdx.x * NTHREADS + C.tid; idx < RW_ELEMS; idx += C.G * NTHREADS) {
        const int r = idx / (48 * 2048), rem = idx % (48 * 2048), o = rem >> 11, k = rem & 2047;
        const float gs = gffn[k] * (1.f + modp(C, l, r, 4)[k]);
        const float w = o < 4 ? wrg[k * 4 + o] : (o < 36 ? wre[k * 32 + (o - 4)] : 0.f);
        RW[idx] = gs * w; if (o == 0) RG[r * 2048 + k] = gs; }
    for (int u = C.gw; u < 5 * 36; u += C.NGW) { const int r = u / 36, o = u % 36; const float* sh2 = modp(C, l, r, 3); float p = 0.f;
        for (int k = C.lane; k < 2048; k += 64) p += sh2[k] * (o < 4 ? wrg[k * 4 + o] : wre[k * 32 + (o - 4)]);
        p = wave_sum(p); if (C.lane == 0) RC[r * 48 + o] = p + (o < 4 ? AIN(I_BRG)[l * 4 + o] : AIN(I_BRE)[l * 32 + (o - 4)]); }
}
template <int NP> __device__ __forceinline__ void router_blocks(const Args& a, const Ctx& C, int l, int blk0, int nblk, bool commit) {
    const float* XL = (const float*)(C.ws + WS_XL);
    int* tokE = (int*)(C.ws + WS_TAB + TB_TOKE); float* tokW = (float*)(C.ws + WS_TAB + TB_TOKW); int* tokP = (int*)(C.ws + WS_TAB + TB_TOKP);
    unsigned* cnt = (unsigned*)(C.ws + WS_CTL) + CW_CNT + l * 64;
    const float* RW = (const float*)(C.ws + WS_RW); const float* RC = RW + RW_ELEMS; float* RS = (float*)(C.ws + WS_TAB + TB_RS);
    constexpr int GPW = 8 / NP, NBATCH = 32 / NP;
    const int pr = C.wave / NP, half = C.wave % NP;
    LAS float* part = (LAS float*)(C.lds + RING_OFF) + (pr * (NP - 1) + (half > 0 ? half - 1 : 0)) * 1024;
    LAS float* lg = (LAS float*)(C.lds + RING_OFF) + 8192 + pr * 1024;
    const int i16 = C.lane & 15, kk = C.lane >> 4;
    const int nit = (nblk + GPW - 1) / GPW;
    for (int it = blockIdx.x; it < nit; it += C.G) {
        const int blk = it * GPW + pr; const bool act = blk < nblk;
        const int row0 = (blk0 + (act ? blk : 0)) * 16, r = row0 < ML ? (row0 >> 12) : 4;
        f32x4 acc[3]; float ss = 0.f;
#pragma unroll
        for (int nt = 0; nt < 3; ++nt) acc[nt] = (f32x4){0.f, 0.f, 0.f, 0.f};
        if (act) {
            const float* xp = XL + (size_t)(row0 + i16) * D + 4 * kk + (2048 / NP) * half; const float* wp = RW + ((size_t)r * 48 + i16) * 2048 + 4 * kk + (2048 / NP) * half;
            f32x4 xr[4][4], wq[2][4][3];
#define RT_LOADX(slot, batch) do { _Pragma("unroll") for (int u = 0; u < 4; ++u) xr[slot][u] = *(const f32x4*)(xp + 16 * (4 * (batch) + u)); } while (0)
#define RT_LOADW(slot, batch) do { _Pragma("unroll") for (int u = 0; u < 4; ++u) _Pragma("unroll") for (int nt = 0; nt < 3; ++nt) wq[slot][u][nt] = *(const f32x4*)(wp + (size_t)nt * 16 * 2048 + 16 * (4 * (batch) + u)); } while (0)
            RT_LOADX(0, 0); RT_LOADX(1, 1); RT_LOADX(2, 2); RT_LOADX(3, 3); RT_LOADW(0, 0);
            __builtin_amdgcn_sched_barrier(0);
#pragma unroll
            for (int bi = 0; bi < NBATCH; ++bi) {
                if (bi + 1 < NBATCH) RT_LOADW((bi + 1) & 1, bi + 1);
                __builtin_amdgcn_sched_barrier(0);
#pragma unroll
                for (int u = 0; u < 4; ++u) { const f32x4 xv = xr[bi & 3][u];
                    ss += (xv.x * xv.x + xv.y * xv.y) + (xv.z * xv.z + xv.w * xv.w);
#pragma unroll
                    for (int m = 0; m < 4; ++m)
#pragma unroll
                        for (int nt = 0; nt < 3; ++nt) acc[nt] = __builtin_amdgcn_mfma_f32_16x16x4f32(xv[m], wq[bi & 1][u][nt][m], acc[nt], 0, 0, 0); }
                if (bi + 4 < NBATCH) RT_LOADX(bi & 3, bi + 4);
                __builtin_amdgcn_sched_barrier(0);
            }
#undef RT_LOADX
#undef RT_LOADW
            if (half) {
#pragma unroll
                for (int nt = 0; nt < 3; ++nt)
#pragma unroll
                    for (int t = 0; t < 4; ++t) part[(nt * 4 + t) * 64 + C.lane] = acc[nt][t];
                part[12 * 64 + C.lane] = ss; }
        }
        __syncthreads();
        if (act && !half) {
#pragma unroll
            for (int pp = 0; pp < NP - 1; ++pp) { const LAS float* pq = part + pp * 1024;
#pragma unroll
                for (int nt = 0; nt < 3; ++nt)
#pragma unroll
                    for (int t = 0; t < 4; ++t) acc[nt][t] += pq[(nt * 4 + t) * 64 + C.lane];
                ss += pq[12 * 64 + C.lane]; }
            ss += __shfl_xor(ss, 16); ss += __shfl_xor(ss, 32);
            const float rs = rsqrtf(ss * (1.f / D) + EPS);
#pragma unroll
            for (int nt = 0; nt < 3; ++nt)
#pragma unroll
                for (int t = 0; t < 4; ++t) lg[(4 * kk + t) * 48 + 16 * nt + i16] = acc[nt][t];
            if (kk == 0) lg[768 + i16] = rs;
        }
        __syncthreads();
        if (act && !half && C.lane < 16 && commit) { const int row = row0 + C.lane; const float rst = lg[768 + C.lane]; const LAS float* lr = lg + C.lane * 48; const float* rc = RC + r * 48;
            float gl[4];
#pragma unroll
            for (int i = 0; i < 4; ++i) gl[i] = rst * lr[i] + rc[i];
            int grp = 0; float gm = gl[0];
#pragma unroll
            for (int i = 1; i < 4; ++i) if (gl[i] > gm) { gm = gl[i]; grp = i; }
            float gz = 0.f;
#pragma unroll
            for (int i = 0; i < 4; ++i) gz += __expf(gl[i] - gm);
            const float pgrp = 1.f / gz;
            int i1 = 0, i2 = -1; float m1 = -3.0e38f, m2 = -3.0e38f;
            for (int i = 0; i < 8; ++i) { const float v = rst * lr[4 + grp * 8 + i] + rc[4 + grp * 8 + i];
                if (v > m1) { m2 = m1; i2 = i1; m1 = v; i1 = i; } else if (v > m2) { m2 = v; i2 = i; } }
            const float e2 = __expf(m2 - m1), w1 = pgrp / (1.f + e2), w2 = pgrp * e2 / (1.f + e2);
            const int ea = grp * 8 + i1, eb = grp * 8 + i2;
            const unsigned pa = atomicAdd(cnt + ea, 1u), pb = atomicAdd(cnt + eb, 1u);
            tokE[2 * row] = ea; tokE[2 * row + 1] = eb; tokW[2 * row] = w1; tokW[2 * row + 1] = w2; tokP[2 * row] = (int)pa; tokP[2 * row + 1] = (int)pb; }
        if (act && !half && kk == 0 && commit) RS[row0 + i16] = lg[768 + i16];
    }
}
__device__ __forceinline__ void ph_norm2_router(const Args& a, const Ctx& C, int l, int nrows, bool commit) {
    router_blocks<2>(a, C, l, 0, ML / 16, commit);
    if (nrows > ML) { __syncthreads(); router_blocks<8>(a, C, l, ML / 16, (nrows - ML) / 16, commit); }
}
__device__ __forceinline__ void ph_moe_gather(const Args& a, const Ctx& C, int l, int nrows) {
    const float* XL = (const float*)(C.ws + WS_XL); unsigned char* XS = (unsigned char*)(C.ws + WS_XS);
    const int* tokE = (const int*)(C.ws + WS_TAB + TB_TOKE); const float* tokW = (const float*)(C.ws + WS_TAB + TB_TOKW); const int* tokP = (const int*)(C.ws + WS_TAB + TB_TOKP);
    int* sdst = (int*)(C.ws + WS_TAB + TB_SDST); float* sw = (float*)(C.ws + WS_TAB + TB_SW); int* tile_e = (int*)(C.ws + WS_TAB + TB_TILEE); int* ntl = (int*)(C.ws + WS_TAB + TB_NT);
    const float* RS = (const float*)(C.ws + WS_TAB + TB_RS); const float* RG = (const float*)(C.ws + WS_RW) + RW_ELEMS + 256;
    const unsigned* cnt = (const unsigned*)(C.ws + WS_CTL) + CW_CNT + l * 64;
    LAS int* sh = (LAS int*)(C.lds + RING_OFF);
    if (C.tid == 0) { int acc = 0; for (int e = 0; e < NE; ++e) { const int c = (int)cnt[e]; sh[e] = acc; sh[64 + e] = c; acc += (c + 255) / 256 * 256; } sh[32] = acc; }
    __syncthreads();
    const int ptot = sh[32];
    if (blockIdx.x == 0) {
        for (int i = C.tid; i < ptot / 256; i += NTHREADS) { int e = 0; while (e < NE - 1 && sh[e + 1] <= i * 256) ++e; tile_e[i] = e; }
        if (C.tid == 0) *ntl = ptot / 256;
    }
    for (int e = blockIdx.x; e < NE; e += C.G) for (int s = sh[e] + sh[64 + e] + C.tid; s < sh[e + 1]; s += NTHREADS) { sdst[s] = -1; sw[s] = 0.f; }
    LAS float* T = (LAS float*)(C.lds + TBL_OFF); { const int rb = stream_batch(C);
        for (int i = C.tid; i < 2 * 2048; i += NTHREADS) { const int set = i >> 11, col = i & 2047, r = set ? 4 : rb; T[(set * 2 + 0) * 2048 + col] = RG[r * 2048 + col]; T[(set * 2 + 1) * 2048 + col] = modp(C, l, r, 3)[col]; } }
    __syncthreads();
    f32x4 xa[8], xb[8]; float rsa = 0.f, rsb = 0.f; v2u ea = {0u, 0u}, eb = {0u, 0u}, pa = {0u, 0u}, pb = {0u, 0u}; float2 wa = {0.f, 0.f}, wb = {0.f, 0.f};
#define MG_LOAD(X, RS_, E, P, W, t) do { const int t_ = (t); RS_ = RS[t_]; E = *(const v2u*)(tokE + 2 * t_); P = *(const v2u*)(tokP + 2 * t_); W = *(const float2*)(tokW + 2 * t_); \
        _Pragma("unroll") for (int j = 0; j < 8; ++j) X[j] = *(const f32x4*)(XL + (size_t)t_ * D + C.lane * 4 + 256 * j); } while (0)
    const int NK = stream_nslots(C);
    int ta = stream_row(C, 0, nrows);
    if (ta >= 0) MG_LOAD(xa, rsa, ea, pa, wa, ta);
    for (int k = 0; k < NK; ++k) {
        const int tb = k + 1 < NK ? stream_row(C, k + 1, nrows) : -1;
        if (tb >= 0) MG_LOAD(xb, rsb, eb, pb, wb, tb);
        __builtin_amdgcn_sched_barrier(0);
        if (ta >= 0) {
            const int s0 = sh[__builtin_amdgcn_readfirstlane((int)ea.x)] + __builtin_amdgcn_readfirstlane((int)pa.x), s1 = sh[__builtin_amdgcn_readfirstlane((int)ea.y)] + __builtin_amdgcn_readfirstlane((int)pa.y);
            const LAS float* Ts = T + (ta < ML ? 0 : 2 * 2048) + C.lane * 4;
            unsigned char* d0 = XS + (size_t)s0 * D + C.lane * 4; unsigned char* d1 = XS + (size_t)s1 * D + C.lane * 4;
#pragma unroll
            for (int j = 0; j < 8; ++j) { const f32x4 gg = *(const LAS f32x4*)(Ts + 256 * j), shv = *(const LAS f32x4*)(Ts + 2048 + 256 * j);
                const f32x4 hv = xa[j] * rsa * gg + shv; const unsigned o = pg8::cvt4_fp8(hv.x, hv.y, hv.z, hv.w); *(unsigned*)(d0 + 256 * j) = o; *(unsigned*)(d1 + 256 * j) = o; }
            if (C.lane == 0) { sdst[s0] = 2 * ta; sw[s0] = wa.x; sdst[s1] = 2 * ta + 1; sw[s1] = wa.y; }
        }
#pragma unroll
        for (int j = 0; j < 8; ++j) xa[j] = xb[j];
        rsa = rsb; ea = eb; pa = pb; wa = wb; ta = tb;
        __builtin_amdgcn_sched_barrier(0);
    }
#undef MG_LOAD
    __syncthreads();
}
__device__ __forceinline__ void ph_final(const Args& a, const Ctx& C) {
    const float* XL = (const float*)(C.ws + WS_XL); const unsigned char* Y = (const unsigned char*)(C.ws + WS_Y); float* out = (float*)AIN(25);
    LAS float* T = (LAS float*)(C.lds + TBL_OFF); { const int rb = stream_batch(C); const float* gf = AIN(I_GFIN);
        for (int i = C.tid; i < 2048; i += NTHREADS) { T[i] = modp(C, DEPTH - 1, rb, 5)[i] * (1.f / pg8::F8_SCY); T[2048 + i] = gf[i]; } }
    __syncthreads();
    f32x4 va[8], vb[8]; int pa[8], qa[8], pb[8], qb[8];
#define FN_LOAD(V, P, Q, rw) do { const int rw_ = (rw); const unsigned char* y0_ = Y + (size_t)(2 * rw_) * D; \
        _Pragma("unroll") for (int j = 0; j < 8; ++j) { V[j] = *(const f32x4*)(XL + (size_t)rw_ * D + C.lane * 4 + 256 * j); P[j] = *(const int*)(y0_ + C.lane * 4 + 256 * j); Q[j] = *(const int*)(y0_ + D + C.lane * 4 + 256 * j); } } while (0)
    const int NK = stream_nslots(C);
    int rowa = stream_row(C, 0, ML);
    if (rowa >= 0) FN_LOAD(va, pa, qa, rowa);
    for (int k = 0; k < NK; ++k) {
        const int rowb = k + 1 < NK ? stream_row(C, k + 1, ML) : -1;
        if (rowb >= 0) FN_LOAD(vb, pb, qb, rowb);
        __builtin_amdgcn_sched_barrier(0);
        if (rowa >= 0) {
            const LAS float* Ts = T + C.lane * 4; float ss = 0.f;
#pragma unroll
            for (int j = 0; j < 8; ++j) { const f32x4 g = *(const LAS f32x4*)(Ts + 256 * j);
                va[j] = va[j] + g * (un4_fp8(pa[j]) + un4_fp8(qa[j]));
                ss += (va[j].x * va[j].x + va[j].y * va[j].y) + (va[j].z * va[j].z + va[j].w * va[j].w); }
            const float rs = rsqrtf(wave_sum(ss) * (1.f / D) + EPS);
#pragma unroll
            for (int j = 0; j < 8; ++j) { const f32x4 g = *(const LAS f32x4*)(Ts + 2048 + 256 * j); *(f32x4*)(out + (size_t)rowa * D + C.lane * 4 + 256 * j) = va[j] * rs * g; }
        }
        if (rowb >= 0) {
#pragma unroll
            for (int j = 0; j < 8; ++j) { va[j] = vb[j]; pa[j] = pb[j]; qa[j] = qb[j]; } }
        rowa = rowb;
        __builtin_amdgcn_sched_barrier(0);
    }
#undef FN_LOAD
}

constexpr int NPH = 2 + 10 * DEPTH;
#ifndef MK_ONE_LAUNCH
#define MK_ONE_LAUNCH 1
#endif
__global__ void __launch_bounds__(NTHREADS, 2) __attribute__((amdgpu_waves_per_eu(2, 2))) fwd(Args args) {
    extern __shared__ __attribute__((aligned(16))) unsigned char lds[];
    unsigned* ctl = (unsigned*)(args.ws + WS_CTL);
#define MKCTX() Ctx C; { int tz_ = threadIdx.x; asm volatile("" : "+v"(tz_)); size_t wo_ = 0; asm volatile("" : "+s"(wo_)); unsigned char* wz_ = args.ws + wo_; \
        C.lds = (LAS unsigned char*)lds; C.tid = tz_; C.lane = tz_ & 63; C.wave = __builtin_amdgcn_readfirstlane(tz_ >> 6); \
        C.G = gridDim.x; C.gw = blockIdx.x * NWAVES + C.wave; C.NGW = C.G * NWAVES; C.ws = wz_; C.mod = (float*)(C.ws + WS_CTL) + CW_MOD; }
    for (int u = threadIdx.x; u < (LDS_BYTES - LDSCTL_OFF) / 4; u += NTHREADS) ((LAS unsigned*)((LAS unsigned char*)lds + LDSCTL_OFF))[u] = 0u;
    __syncthreads();
    if (threadIdx.x < 26) { const unsigned long long off = (unsigned long long)((const char*)(threadIdx.x < 25 ? (const void*)args.in[threadIdx.x < 25 ? threadIdx.x : 0] : (const void*)args.out) - (const char*)args.ws);
        ((LAS unsigned long long*)((LAS unsigned char*)lds + ARGS_OFF))[threadIdx.x] = off; }
    __syncthreads();
#if MK_ONE_LAUNCH
    constexpr int lo = 0, hi = NPH;
#else
    const int lo = args.ph_lo, hi = args.ph_hi;
#endif
    XcdBarrier bar; bar.bar = ctl + CW_BAR; bar.x = 0; bar.st = nullptr;
    if (hi - lo > 1) bar = xcd_barrier_post(ctl + CW_BAR, (volatile LAS unsigned*)((LAS unsigned char*)lds + MISC_OFF) + 8);
#define IN(k) (lo <= (k) && (k) < hi)
#define SEAM(k) do { if (IN(k) && IN((k) + 1)) { XcdBarrier bl_ = bar; size_t z_ = 0; asm volatile("" : "+s"(z_)); bl_.bar = bar.bar + z_; bl_.x = xb_xcc_id(); xcd_barrier(bl_); } } while (0)

    if (IN(0)) { MKCTX(); unsigned* sb = (unsigned*)(C.ws + WS_CTL) + CW_SB;
        ph_mod(args, C); sb_arrive(sb);
        ph_conv_dense_w(args, C); ph_conv_expert_w(args, C, 0, true);
        sb_wait(sb, (unsigned)C.G, (unsigned*)(C.ws + WS_CTL) + CW_BAR);
        ph_norm1_tables(C, 0); __syncthreads(); ph_router_prep(args, C, 0); ph_norm1(args, C, 0);
        SEAM(0); }

#pragma unroll 1
    for (int l = 0; l < DEPTH; ++l) {
        const int pb = 1 + 10 * l; const bool last = (l == DEPTH - 1); const int nrows = last ? ML : MT;
        if (l > 0 && IN(pb + 0)) { MKCTX(); ph_norm1_tables(C, l); __syncthreads(); { ph_conv_expert_w(args, C, l, false); } { ph_router_prep(args, C, l); ph_norm1(args, C, l); } SEAM(pb + 0); }
        if (IN(pb + 1)) {
            MKCTX();
            pg8::Gemm g{(const bf16*)(C.ws + WS_H), (const bf16*)(C.ws + WS_WIN) + (size_t)l * IN_DIM * D, MT, IN_DIM, D};
            pg8::InProjOrder S{C.G, (int)blockIdx.x}; pg8::EpiInProj E{(bf16*)(C.ws + WS_U), (bf16*)(C.ws + WS_VT)};
            pg8::gemm_phase<pg8::EpiInProj, pg8::InProjOrder, true, true>(C.lds + RING_OFF, g, S, E);
            SEAM(pb + 1); }
#ifndef DUP_HG
#define DUP_HG 1
#define DUP_CV 1
#define DUP_NA 1
#define DUP_RO 1
#define DUP_SC 1
#endif
        if (IN(pb + 2)) { MKCTX(); unsigned* sb = (unsigned*)(C.ws + WS_CTL) + CW_SB + 64 * (1 + l);
            for (int rep_ = 0; rep_ < DUP_HG; ++rep_) { ph_hgrn_a(args, C, l); __syncthreads(); }
            sb_arrive(sb);
            conv_stage_w(args, C, l); __syncthreads(); for (int rep_ = 0; rep_ < DUP_CV; ++rep_) { ph_conv(args, C, l, nrows); } __syncthreads();
            for (int rep_ = 0; rep_ < DUP_NA; ++rep_) { ph_attn_lds<true>(args, C, l); if (!last) ph_attn_lds<false>(args, C, l); }
            sb_wait(sb, (unsigned)C.G, (unsigned*)(C.ws + WS_CTL) + CW_BAR);
            for (int rep_ = 0; rep_ < DUP_SC; ++rep_) { ph_hgrn_scan(C); }
            SEAM(pb + 2); }
        if (IN(pb + 4)) { MKCTX(); for (int rep_ = 0; rep_ < DUP_RO; ++rep_) { ph_hgrn_readout(args, C, l, last); } SEAM(pb + 4); }
        if (IN(pb + 5)) {
            MKCTX();
            int kd = D; asm volatile("" : "+s"(kd));
            pg8::Gemm g{(const bf16*)(C.ws + WS_CAT), (const bf16*)(C.ws + WS_WOUT + (size_t)l * D * D), nrows, D, kd};
            pg8::StaticOrder S; S.init(nrows, D, C.G, (int)blockIdx.x);
            float* XL = (float*)(C.ws + WS_XL);
            pg8::EpiRes E{l == 0 ? AIN(I_X) : XL, l == 0 ? AIN(I_CTX) : XL + (size_t)ML * D, XL, C.mod + (size_t)l * 5 * 12288 + 2 * 2048};
            pg8::gemm_phase<pg8::EpiRes, pg8::StaticOrder, false, true, true>(C.lds + RING_OFF, g, S, E);
            SEAM(pb + 5); }
        if (IN(pb + 6)) { MKCTX(); { ph_norm2_router(args, C, l, nrows, true); } SEAM(pb + 6); }
        if (IN(pb + 7)) { MKCTX(); { ph_moe_gather(args, C, l, nrows); } SEAM(pb + 7); }
        if (IN(pb + 8)) {
            MKCTX();
            const int ntiles = __builtin_amdgcn_readfirstlane(*(const int*)(C.ws + WS_TAB + TB_NT));
            LAS int* tl = (LAS int*)(C.lds + TILE_LDS_OFF); if (C.tid < MOE_TILES_MAX) tl[C.tid] = ((const int*)(C.ws + WS_TAB + TB_TILEE))[C.tid < ntiles ? C.tid : 0]; __syncthreads();
            int kd = D; asm volatile("" : "+s"(kd));
            pg8::Gemm g{(const bf16*)(C.ws + WS_XS), (const bf16*)(C.ws + WS_WE1), ntiles * 256, 1024, kd};
            pg8::GroupedOrder S{tl, ntiles, 4, C.G, (int)blockIdx.x, (size_t)1024 * D};
            pg8::EpiGLU E{(unsigned char*)(C.ws + WS_ACT)};
            pg8::gemm_phase<pg8::EpiGLU, pg8::GroupedOrder, true, true, true>(C.lds + RING_OFF, g, S, E);
            SEAM(pb + 8); }
        if (IN(pb + 9)) {
            MKCTX();
            const int ntiles = __builtin_amdgcn_readfirstlane(*(const int*)(C.ws + WS_TAB + TB_NT));
            LAS int* tl = (LAS int*)(C.lds + TILE_LDS_OFF); if (C.tid < MOE_TILES_MAX) tl[C.tid] = ((const int*)(C.ws + WS_TAB + TB_TILEE))[C.tid < ntiles ? C.tid : 0]; __syncthreads();
            int kde = DE; asm volatile("" : "+s"(kde));
            pg8::Gemm g{(const bf16*)(C.ws + WS_ACT), (const bf16*)(C.ws + WS_WE2), ntiles * 256, D, kde};
            pg8::GroupedOrder S{tl, ntiles, 8, C.G, (int)blockIdx.x, (size_t)D * DE};
            pg8::EpiScatter E{(unsigned char*)(C.ws + WS_Y), (const int*)(C.ws + WS_TAB + TB_SDST), (const float*)(C.ws + WS_TAB + TB_SW)};
            pg8::gemm_phase<pg8::EpiScatter, pg8::GroupedOrder, false, false, true>(C.lds + RING_OFF, g, S, E);
            SEAM(pb + 9); }
    }
    if (IN(NPH - 1)) { MKCTX(); { ph_final(args, C); } }
#undef IN
#undef SEAM
}

extern "C" void kernel_launch(void* const* d_in, const int* in_sizes, int n_in, void* d_out, int out_size, void* d_ws, size_t ws_size, hipStream_t stream) {
    static int grid = 0;
    if (grid == 0) {
        if (n_in != 25 || in_sizes[0] != ML * D || out_size != ML * D || ws_size < WS_END) {
            fprintf(stderr, "kernel_launch: unexpected shapes: n_in %d in0 %d out %d ws %zu (need %zu)\n", n_in, n_in > 0 ? in_sizes[0] : -1, out_size, ws_size, (size_t)WS_END); grid = -1; return; }
        int dev = 0, cus = 0, per_cu = 0;
        if (hipGetDevice(&dev) != hipSuccess || hipDeviceGetAttribute(&cus, hipDeviceAttributeMultiprocessorCount, dev) != hipSuccess) { grid = -1; return; }
        if (hipFuncSetAttribute((const void*)fwd, hipFuncAttributeMaxDynamicSharedMemorySize, LDS_BYTES) != hipSuccess) { fprintf(stderr, "kernel_launch: hipFuncSetAttribute failed\n"); grid = -1; return; }
        if (hipOccupancyMaxActiveBlocksPerMultiprocessor(&per_cu, (const void*)fwd, NTHREADS, LDS_BYTES) != hipSuccess || per_cu < 1)
            fprintf(stderr, "kernel_launch: note: occupancy query reports %d workgroups per CU\n", per_cu);
        (void)hipGetLastError();
        grid = cus & ~7;
    }
    if (grid < 0) return;
    if (hipMemsetAsync((char*)d_ws + WS_CTL, 0, CTL_ZERO_BYTES, stream) != hipSuccess) { fprintf(stderr, "kernel_launch: memset failed\n"); return; }
    Args a{};
    for (int i = 0; i < 25; ++i) a.in[i] = (const float*)d_in[i];
    a.out = (float*)d_out; a.ws = (unsigned char*)d_ws;
#if MK_ONE_LAUNCH
    a.ph_lo = 0; a.ph_hi = NPH;
    hipLaunchKernelGGL(fwd, dim3(grid), dim3(NTHREADS), LDS_BYTES, stream, a);
#else
    for (int ph = 0; ph < NPH; ++ph) { a.ph_lo = ph; a.ph_hi = ph + 1; hipLaunchKernelGGL(fwd, dim3(grid), dim3(NTHREADS), LDS_BYTES, stream, a); }
#endif
    const hipError_t le = hipPeekAtLastError();
    if (le != hipSuccess) fprintf(stderr, "kernel_launch: launch failed: %s\n", hipGetErrorName(le));
}
```

```cpp
#include <hip/hip_runtime.h>
#include <cstdio>
#include <cstdint>
namespace pg8 {
#define PG8_LAS __attribute__((address_space(3)))
typedef unsigned short bf16_t;
typedef short bf16x8 __attribute__((ext_vector_type(8)));
typedef float f32x4 __attribute__((ext_vector_type(4)));
typedef unsigned u32x4 __attribute__((ext_vector_type(4)));
typedef int v8i_t __attribute__((ext_vector_type(8)));
typedef int i32x4_t __attribute__((ext_vector_type(4)));
constexpr int BM = 256, BK = 64, HALF = 128, HTB = HALF * BK * 2  , STAGE_BYTES = 8 * HTB, NXCD = 8, WGM = 8;

__host__ __device__ __forceinline__ int lds_byte(int r, int c) { const int st = (r >> 4) * 2 + (c >> 5), rr = r & 15, cc = c & 31, ob = rr * 64 + cc * 2; return st * 1024 + (ob ^ (((ob >> 9) & 1) << 5)); }
__host__ __device__ __forceinline__ void stage_rc(int b, int& R, int& C) { const int st = b / 1024, sb = b % 1024, swz = sb ^ (((sb >> 9) & 1) << 5); R = (st >> 1) * 16 + swz / 64; C = (st & 1) * 32 + (swz % 64) / 2; }
__host__ __device__ __forceinline__ int perm32(int rho) { const int n = rho >> 4, i = rho & 15; return 8 * (i >> 2) + 4 * n + (i & 3); }


struct Unit { int pm, pn; };
struct Gemm { const bf16_t* A; const bf16_t* Bt; int M, N, K; };

struct StaticOrder {
    int nM, nN, nwg, G, c;
    __host__ __device__ void init(int M, int N, int G_, int c_) { nM = M / BM; nN = N / BM; nwg = nM * nN; G = G_; c = c_; }
    __host__ __device__ bool next(int i, Unit& u) const {
        const long L = (long)i * G + c; if (L >= nwg) return false;
        int wgid = (int)L; { const int q = nwg / NXCD, r = nwg % NXCD, xcd = wgid % NXCD, off = wgid / NXCD; wgid = (xcd < r ? xcd * (q + 1) : r * (q + 1) + (xcd - r) * q) + off; }
        const int nig = WGM * nN, gid = wgid / nig, fm = gid * WGM, gsz = (nM - fm) < WGM ? (nM - fm) : WGM;
        u.pm = fm + ((wgid % nig) % gsz); u.pn = (wgid % nig) / gsz; return true;
    }
    __device__ __forceinline__ const char* aptr(const Gemm& g, const Unit& u, size_t tstep) const { return (const char*)g.A + (size_t)u.pm * tstep; }
    __device__ __forceinline__ const char* bptr(const Gemm& g, const Unit& u, size_t tstep) const { return (const char*)g.Bt + (size_t)u.pn * tstep; }
    __device__ __forceinline__ void a_ready(const Unit&) const {}
    __device__ __forceinline__ void done(const Unit&) const {}
};
struct GroupedOrder {
    const PG8_LAS int* tile_e; int ntiles, nN, G, c; size_t estride;
    __device__ bool next(int i, Unit& u) const {
        const int x = c & 7, bi = c >> 3, nbx = G >> 3, T8 = (ntiles + 7) >> 3;
        const int lu = i * nbx + bi, pm = x * T8 + lu / nN;
        if (lu >= T8 * nN || pm >= ntiles) return false;
        u.pm = pm; u.pn = lu % nN; return true;
    }
    __device__ __forceinline__ const char* aptr(const Gemm& g, const Unit& u, size_t tstep) const { return (const char*)g.A + (size_t)u.pm * tstep; }
    __device__ __forceinline__ const char* bptr(const Gemm& g, const Unit& u, size_t tstep) const { return (const char*)g.Bt + (size_t)__builtin_amdgcn_readfirstlane(tile_e[u.pm]) * estride + (size_t)u.pn * tstep; }
    __device__ __forceinline__ void a_ready(const Unit&) const {}
    __device__ __forceinline__ void done(const Unit&) const {}
};

struct InProjOrder {
    int G, c;
    static __host__ __device__ __forceinline__ int coltile(int pn20) { return pn20 < 12 ? pn20 : (pn20 < 14 ? pn20 + 4 : pn20 + 6); }
    static __host__ __device__ __forceinline__ int wrow(int t) { return t < 4 ? 3072 + 256 * t : 4608 + 256 * (t - 4); }
    __device__ bool next(int i, Unit& u) const {
        const int L = i * G + c; if (L >= 1768) return false;
        if (L < 1360) { constexpr int nM = 68, nN = 20, nwg = 1360; int wgid = L; { const int q = nwg / NXCD, xcd = wgid % NXCD, off = wgid / NXCD; wgid = xcd * q + off; }
            const int nig = WGM * nN, gid = wgid / nig, fm = gid * WGM, gsz = (nM - fm) < WGM ? (nM - fm) : WGM;
            u.pm = fm + ((wgid % nig) % gsz); u.pn = (wgid % nig) / gsz; }
        else { const int Ls = L - 1360; u.pm = Ls / 68; u.pn = 100 + Ls % 68; }
        return true;
    }
    __device__ __forceinline__ const char* aptr(const Gemm& g, const Unit& u, size_t tstep) const {
        return u.pn >= 100 ? (const char*)g.Bt + (size_t)wrow(u.pm) * g.K * 2 : (const char*)g.A + (size_t)u.pm * tstep; }
    __device__ __forceinline__ const char* bptr(const Gemm& g, const Unit& u, size_t tstep) const {
        return u.pn >= 100 ? (const char*)g.A + (size_t)(u.pn - 100) * tstep : (const char*)g.Bt + (size_t)coltile(u.pn) * tstep; }
    __device__ __forceinline__ void a_ready(const Unit&) const {}
    __device__ __forceinline__ void done(const Unit&) const {}
};

typedef unsigned u32x2s __attribute__((ext_vector_type(2)));
typedef __bf16 bf16x2_t __attribute__((ext_vector_type(2)));
typedef float f32x2_t __attribute__((ext_vector_type(2)));
__device__ __forceinline__ unsigned cvt_pk_bf16(float lo, float hi) { const f32x2_t f = {lo, hi}; const bf16x2_t v = __builtin_convertvector(f, bf16x2_t); return __builtin_bit_cast(unsigned, v); }

__device__ __forceinline__ unsigned cvt4_fp8(float a, float b, float c, float d) {
    a = fminf(fmaxf(a, -440.f), 440.f); b = fminf(fmaxf(b, -440.f), 440.f); c = fminf(fmaxf(c, -440.f), 440.f); d = fminf(fmaxf(d, -440.f), 440.f);
    int w = 0; w = __builtin_amdgcn_cvt_pk_fp8_f32(a, b, w, false); w = __builtin_amdgcn_cvt_pk_fp8_f32(c, d, w, true); return (unsigned)w; }
constexpr float F8_SC1 = 32.f, F8_SC2 = 16.f, F8_SCY = 16.f;

struct EpiU {
    static constexpr bool PERM = true, AFTER_DRAIN = false;
    bf16_t* O; int ldc;
    __device__ __forceinline__ void operator()(const f32x4 (&acc)[2][2][4][2], const Unit& u, int wr, int wc, int fr, int fq) const {
        const int row0 = u.pm * BM + wr * 64 + fr, col0 = u.pn * BM + wc * 32 + 8 * fq;
#pragma unroll
        for (int ai = 0; ai < 2; ++ai)
#pragma unroll
            for (int m = 0; m < 4; ++m) { bf16_t* rowp = O + (size_t)(row0 + ai * HALF + m * 16) * ldc + col0;
#pragma unroll
                for (int bj = 0; bj < 2; ++bj) { const f32x4 v0 = acc[ai][bj][m][0], v1 = acc[ai][bj][m][1];
                    u32x4 w; w.x = cvt_pk_bf16(v0[0], v0[1]); w.y = cvt_pk_bf16(v0[2], v0[3]); w.z = cvt_pk_bf16(v1[0], v1[1]); w.w = cvt_pk_bf16(v1[2], v1[3]);
                    *(u32x4*)(rowp + bj * HALF) = w; } }
    }
};
struct EpiInProj {
    static constexpr bool PERM = true, AFTER_DRAIN = false;
    bf16_t* Uo; bf16_t* VT;
    __device__ __forceinline__ void operator()(const f32x4 (&acc)[2][2][4][2], const Unit& u, int wr, int wc, int fr, int fq) const {
        const bool sw = u.pn >= 100;
        if (!sw && u.pn < 4) {
            const int row0 = u.pm * BM + wr * 64 + fr, col0 = u.pn * HALF + wc * 32 + 8 * fq;
#pragma unroll
            for (int ai = 0; ai < 2; ++ai)
#pragma unroll
                for (int m = 0; m < 4; ++m) { float r[8];
#pragma unroll
                    for (int n = 0; n < 2; ++n)
#pragma unroll
                        for (int j = 0; j < 4; ++j) r[n * 4 + j] = acc[ai][0][m][n][j] * __builtin_amdgcn_rcpf(1.f + __expf(-acc[ai][1][m][n][j]));
                    u32x4 w; w.x = cvt_pk_bf16(r[0], r[1]); w.y = cvt_pk_bf16(r[2], r[3]); w.z = cvt_pk_bf16(r[4], r[5]); w.w = cvt_pk_bf16(r[6], r[7]);
                    *(u32x4*)(Uo + (size_t)(row0 + ai * HALF + m * 16) * 6656 + col0) = w; }
            return; }
        bf16_t* O = sw ? VT : Uo; const int ldc = sw ? 17408 : 6656;
        const int row0 = u.pm * BM + wr * 64 + fr, col0 = (sw ? (u.pn - 100) : InProjOrder::coltile(u.pn)) * BM + wc * 32 + 8 * fq;
#pragma unroll
        for (int ai = 0; ai < 2; ++ai)
#pragma unroll
            for (int m = 0; m < 4; ++m) { bf16_t* rowp = O + (size_t)(row0 + ai * HALF + m * 16) * ldc + col0;
#pragma unroll
                for (int bj = 0; bj < 2; ++bj) { const f32x4 v0 = acc[ai][bj][m][0], v1 = acc[ai][bj][m][1];
                    u32x4 w; w.x = cvt_pk_bf16(v0[0], v0[1]); w.y = cvt_pk_bf16(v0[2], v0[3]); w.z = cvt_pk_bf16(v1[0], v1[1]); w.w = cvt_pk_bf16(v1[2], v1[3]);
                    *(u32x4*)(rowp + bj * HALF) = w; } }
    }
};
struct EpiRes {
    static constexpr bool PERM = false, AFTER_DRAIN = false;
    const float* res0; const float* res1; float* out; const float* ga;
    __device__ __forceinline__ void operator()(const f32x4 (&acc)[2][2][4][2], const Unit& u, int wr, int wc, int fr, int fq) const {
        const int row0 = u.pm * BM + wr * 64 + fr, col0 = u.pn * BM + wc * 32 + 4 * fq;
        const bool lat = u.pm < 64; const int mr = lat ? (u.pm >> 4) : 4;
        const float* gap = ga + mr * 12288 + col0;
        const float* rp0 = (lat ? res0 + (size_t)row0 * 2048 : res1 + (size_t)(row0 - 16384) * 2048) + col0;
        float* op0 = out + (size_t)row0 * 2048 + col0;
        f32x4 gv[2][2];
#pragma unroll
        for (int bj = 0; bj < 2; ++bj)
#pragma unroll
            for (int n = 0; n < 2; ++n) gv[bj][n] = *(const f32x4*)(gap + bj * HALF + n * 16) * (1.f / F8_SC1);
#pragma unroll
        for (int ai = 0; ai < 2; ++ai)
#pragma unroll
            for (int m = 0; m < 4; ++m) { f32x4 rv[2][2];
#pragma unroll
                for (int bj = 0; bj < 2; ++bj)
#pragma unroll
                    for (int n = 0; n < 2; ++n) rv[bj][n] = *(const f32x4*)(rp0 + (size_t)(ai * HALF + m * 16) * 2048 + bj * HALF + n * 16);
                __builtin_amdgcn_sched_barrier(0);
#pragma unroll
                for (int bj = 0; bj < 2; ++bj)
#pragma unroll
                    for (int n = 0; n < 2; ++n) *(f32x4*)(op0 + (size_t)(ai * HALF + m * 16) * 2048 + bj * HALF + n * 16) = rv[bj][n] + gv[bj][n] * acc[ai][bj][m][n];
                __builtin_amdgcn_sched_barrier(0); }
    }
};
struct EpiGLU {
    static constexpr bool PERM = true, AFTER_DRAIN = false;
    unsigned char* O;
    __device__ __forceinline__ void operator()(const f32x4 (&acc)[2][2][4][2], const Unit& u, int wr, int wc, int fr, int fq) const {
        const int row0 = u.pm * BM + wr * 64 + fr, col0 = u.pn * HALF + wc * 32 + 8 * fq;
#pragma unroll
        for (int ai = 0; ai < 2; ++ai)
#pragma unroll
            for (int m = 0; m < 4; ++m) { unsigned char* rowp = O + (size_t)(row0 + ai * HALF + m * 16) * 512 + col0;
                float r[8];
#pragma unroll
                for (int n = 0; n < 2; ++n)
#pragma unroll
                    for (int j = 0; j < 4; ++j) { const float g = acc[ai][0][m][n][j] * (1.f / F8_SC1), up = acc[ai][1][m][n][j] * (1.f / F8_SC1); r[n * 4 + j] = g * up * __builtin_amdgcn_rcpf(1.f + __expf(-g)); }
                u32x2s w; w.x = cvt4_fp8(r[0], r[1], r[2], r[3]); w.y = cvt4_fp8(r[4], r[5], r[6], r[7]);
                *(u32x2s*)rowp = w; }
    }
};
struct EpiScatter {
    static constexpr bool PERM = true, AFTER_DRAIN = false;
    unsigned char* Y; const int* sdst; const float* sw;
    __device__ __forceinline__ void operator()(const f32x4 (&acc)[2][2][4][2], const Unit& u, int wr, int wc, int fr, int fq) const {
        const int row0 = u.pm * BM + wr * 64 + fr, col0 = u.pn * BM + wc * 32 + 8 * fq;
#pragma unroll
        for (int ai = 0; ai < 2; ++ai) { int dst[4]; float w[4];
#pragma unroll
            for (int m = 0; m < 4; ++m) { const int slot = row0 + ai * HALF + m * 16; dst[m] = sdst[slot]; w[m] = sw[slot] * (F8_SCY / F8_SC2); }
            __builtin_amdgcn_sched_barrier(0);
#pragma unroll
            for (int m = 0; m < 4; ++m) {
                if (dst[m] >= 0) { unsigned char* rowp = Y + (size_t)dst[m] * 2048 + col0;
#pragma unroll
                    for (int bj = 0; bj < 2; ++bj) { const f32x4 v0 = acc[ai][bj][m][0] * w[m], v1 = acc[ai][bj][m][1] * w[m];
                        u32x2s o; o.x = cvt4_fp8(v0[0], v0[1], v0[2], v0[3]); o.y = cvt4_fp8(v1[0], v1[1], v1[2], v1[3]);
                        *(u32x2s*)(rowp + bj * HALF) = o; } } }
            __builtin_amdgcn_sched_barrier(0); }
    }
};

template <class Epi, class Sched, bool ALIGN_EPI = false, bool SP2 = false, bool F8 = false>
__device__ __forceinline__ void gemm_phase(PG8_LAS unsigned char* lds, const Gemm g, const Sched& S, const Epi& E) {
    int tid_ = threadIdx.x; asm volatile("" : "+v"(tid_));
    const int tid = tid_, wid = __builtin_amdgcn_readfirstlane(tid >> 6), lane = tid & 63, wr = wid >> 2, wc = wid & 3, fr = lane & 15, fq = lane >> 4;
    const int KB = F8 ? g.K : g.K * 2, nt = KB / 128;
    unsigned voffA[2], voffB[2];
#pragma unroll
    for (int i = 0; i < 2; ++i) { int R, C; stage_rc(tid * 16 + i * 8192, R, C); const int Rb = Epi::PERM ? ((R & ~31) + perm32(R & 31)) : R;
        voffA[i] = (unsigned)(R * KB + C * 2); voffB[i] = (unsigned)(Rb * KB + C * 2); }
    const size_t kstep = (size_t)128;
    const size_t hstep = (size_t)HALF * KB;
    const size_t tstep = 2 * hstep;
    const unsigned ldsw = (unsigned)wid * 1024u;
    const int aoff = lds_byte(wr * 64 + fr, fq * 8), boff = lds_byte(wc * 32 + fr, fq * 8);
    const int aoff8a = lds_byte(wr * 64 + fr, fq * 16), boff8a = lds_byte(wc * 32 + fr, fq * 16);
#define PG8_SA(b, h) (((b) * 2 + (h)) * HTB)
#define PG8_SB(b, h) ((4 + (b) * 2 + (h)) * HTB)
#define PG8_STAGE(bufoff, gbase, voff) do { _Pragma("unroll") for (int _i = 0; _i < 2; ++_i) \
        __builtin_amdgcn_global_load_lds((const unsigned*)((const char*)(gbase) + (voff)[_i]), (PG8_LAS unsigned*)(lds + (bufoff) + ldsw + _i * 8192), 16, 0, 0); } while (0)
#define PG8_LDA(dst, b, h) do { if constexpr (F8) { _Pragma("unroll") for (int m = 0; m < 4; ++m) dst##8[m] = *(const PG8_LAS v8i_t*)(lds + PG8_SA(b, h) + aoff8a + m * 2048); } \
        else { _Pragma("unroll") for (int m = 0; m < 4; ++m) _Pragma("unroll") for (int k = 0; k < 2; ++k) dst[m][k] = *(const PG8_LAS bf16x8*)(lds + PG8_SA(b, h) + aoff + m * 2048 + k * 1024); } } while (0)
#define PG8_LDB(dst, b, h) do { if constexpr (F8) { _Pragma("unroll") for (int n = 0; n < 2; ++n) dst##8[n] = *(const PG8_LAS v8i_t*)(lds + PG8_SB(b, h) + boff8a + n * 2048); } \
        else { _Pragma("unroll") for (int n = 0; n < 2; ++n) _Pragma("unroll") for (int k = 0; k < 2; ++k) dst[n][k] = *(const PG8_LAS bf16x8*)(lds + PG8_SB(b, h) + boff + n * 2048 + k * 1024); } } while (0)
#define PG8_MMA(ai, bj, At, Bt) do { __builtin_amdgcn_s_setprio(1); if constexpr (F8) { _Pragma("unroll") for (int m = 0; m < 4; ++m) _Pragma("unroll") for (int n = 0; n < 2; ++n) \
            asm volatile("v_mfma_scale_f32_16x16x128_f8f6f4 %0, %1, %2, %0, %3, %3 op_sel_hi:[0,0,0]" : "+v"(acc[ai][bj][m][n]) : "v"(Bt##8[n]), "v"(At##8[m]), "v"(f8one)); } \
        else { _Pragma("unroll") for (int m = 0; m < 4; ++m) _Pragma("unroll") for (int n = 0; n < 2; ++n) _Pragma("unroll") for (int k = 0; k < 2; ++k) \
            acc[ai][bj][m][n] = __builtin_amdgcn_mfma_f32_16x16x32_bf16(Bt[n][k], At[m][k], acc[ai][bj][m][n], 0, 0, 0); } __builtin_amdgcn_s_setprio(0); } while (0)
#define PG8_WAIT_V(n) asm volatile("s_waitcnt vmcnt(" #n ")" ::: "memory")
#define PG8_WAIT_L(n) asm volatile("s_waitcnt lgkmcnt(" #n ")" ::: "memory")
#define PG8_BAR __builtin_amdgcn_s_barrier()
#define PG8_SCHED __builtin_amdgcn_sched_barrier(0)
    Unit cur, nxt; int ui = 0;
    if (!S.next(0, cur)) return;
    f32x4 acc[2][2][4][2];
#pragma unroll
    for (int a = 0; a < 2; ++a)
#pragma unroll
        for (int b = 0; b < 2; ++b)
#pragma unroll
            for (int m = 0; m < 4; ++m)
#pragma unroll
                for (int n = 0; n < 2; ++n) acc[a][b][m][n] = (f32x4){0.f, 0.f, 0.f, 0.f};
    bf16x8 At[4][2], B0[2][2], B1[2][2]; v8i_t At8[4], B08[2], B18[2];
    const int f8one = 0x7f7f7f7f;
    const char* cA = S.aptr(g, cur, tstep); const char* cB = S.bptr(g, cur, tstep);
    S.a_ready(cur);
    if constexpr (SP2) {
        PG8_STAGE(PG8_SB(0, 0), cB, voffB); PG8_STAGE(PG8_SB(0, 1), cB + hstep, voffB); PG8_STAGE(PG8_SA(0, 0), cA, voffA); PG8_STAGE(PG8_SA(0, 1), cA + hstep, voffA);
        if (wr == 1) PG8_BAR;
        PG8_WAIT_V(2); PG8_BAR;
        PG8_STAGE(PG8_SB(1, 0), cB + kstep, voffB); PG8_STAGE(PG8_SA(1, 0), cA + kstep, voffA); PG8_STAGE(PG8_SB(1, 1), cB + hstep + kstep, voffB);
        PG8_WAIT_V(6); PG8_BAR;
    } else {
        PG8_STAGE(PG8_SB(0, 0), cB, voffB); PG8_STAGE(PG8_SA(0, 0), cA, voffA); PG8_STAGE(PG8_SB(0, 1), cB + hstep, voffB); PG8_STAGE(PG8_SA(0, 1), cA + hstep, voffA);
        if (wr == 1) PG8_BAR;
        PG8_WAIT_V(4); PG8_BAR;
        PG8_STAGE(PG8_SB(1, 0), cB + kstep, voffB); PG8_STAGE(PG8_SA(1, 0), cA + kstep, voffA); PG8_STAGE(PG8_SB(1, 1), cB + hstep + kstep, voffB);
        PG8_WAIT_V(6); PG8_BAR;
    }
    for (;;) {
        const bool has_next = S.next(ui + 1, nxt);
        const char* nA = has_next ? S.aptr(g, nxt, tstep) : cA; const char* nB = has_next ? S.bptr(g, nxt, tstep) : cB;
        for (int t = 0; t < nt; t += 2) {
            const bool last = (t == nt - 2);
            const char* a1 = cA + (size_t)(t + 1) * kstep;
            const char* a2 = last ? nA : cA + (size_t)(t + 2) * kstep; const char* b2 = last ? nB : cB + (size_t)(t + 2) * kstep;
            const char* a3 = a2 + kstep; const char* b3 = b2 + kstep;
            if (last && has_next) S.a_ready(nxt);
            if constexpr (SP2) {
            PG8_LDB(B0, 0, 0); PG8_LDB(B1, 0, 1); PG8_SCHED; PG8_LDA(At, 0, 0); PG8_STAGE(PG8_SA(1, 1), a1 + hstep, voffA);
            PG8_WAIT_V(8); PG8_WAIT_L(0); PG8_BAR; PG8_MMA(0, 0, At, B0); PG8_MMA(0, 1, At, B1); PG8_BAR; PG8_SCHED;
            PG8_LDA(At, 0, 1); PG8_STAGE(PG8_SB(0, 0), b2, voffB); PG8_STAGE(PG8_SB(0, 1), b2 + hstep, voffB); PG8_STAGE(PG8_SA(0, 0), a2, voffA);
            PG8_WAIT_V(8); PG8_WAIT_L(0); PG8_BAR; PG8_MMA(1, 0, At, B0); PG8_MMA(1, 1, At, B1); PG8_BAR; PG8_SCHED;
            PG8_LDB(B0, 1, 0); PG8_LDB(B1, 1, 1); PG8_SCHED; PG8_LDA(At, 1, 0); PG8_STAGE(PG8_SA(0, 1), a2 + hstep, voffA);
            PG8_WAIT_V(8); PG8_WAIT_L(0); PG8_BAR; PG8_MMA(0, 0, At, B0); PG8_MMA(0, 1, At, B1); PG8_BAR; PG8_SCHED;
            PG8_LDA(At, 1, 1); PG8_STAGE(PG8_SB(1, 0), b3, voffB); PG8_STAGE(PG8_SB(1, 1), b3 + hstep, voffB); PG8_STAGE(PG8_SA(1, 0), a3, voffA);
            PG8_WAIT_V(8); PG8_WAIT_L(0); PG8_BAR; PG8_MMA(1, 0, At, B0); PG8_MMA(1, 1, At, B1); PG8_BAR; PG8_SCHED;
            } else {
            PG8_LDB(B0, 0, 0); PG8_SCHED; PG8_LDA(At, 0, 0); PG8_STAGE(PG8_SA(1, 1), a1 + hstep, voffA);
            PG8_WAIT_L(8); PG8_BAR; PG8_WAIT_L(0); PG8_MMA(0, 0, At, B0); PG8_BAR; PG8_SCHED;
            PG8_LDB(B1, 0, 1); PG8_STAGE(PG8_SB(0, 0), b2, voffB);
            PG8_BAR; PG8_WAIT_L(0); PG8_MMA(0, 1, At, B1); PG8_BAR;
            PG8_LDA(At, 0, 1); PG8_STAGE(PG8_SA(0, 0), a2, voffA);
            PG8_BAR; PG8_WAIT_L(0); PG8_MMA(1, 0, At, B0); PG8_BAR; PG8_SCHED;
            PG8_STAGE(PG8_SB(0, 1), b2 + hstep, voffB);
            PG8_WAIT_V(6); PG8_BAR; PG8_MMA(1, 1, At, B1); PG8_BAR;
            PG8_LDB(B0, 1, 0); PG8_SCHED; PG8_LDA(At, 1, 0); PG8_STAGE(PG8_SA(0, 1), a2 + hstep, voffA);
            PG8_WAIT_L(8); PG8_BAR; PG8_WAIT_L(0); PG8_MMA(0, 0, At, B0); PG8_BAR; PG8_SCHED;
            PG8_LDB(B1, 1, 1); PG8_STAGE(PG8_SB(1, 0), b3, voffB);
            PG8_BAR; PG8_WAIT_L(0); PG8_MMA(0, 1, At, B1); PG8_BAR;
            PG8_LDA(At, 1, 1); PG8_STAGE(PG8_SA(1, 0), a3, voffA);
            PG8_BAR; PG8_WAIT_L(0); PG8_MMA(1, 0, At, B0); PG8_BAR; PG8_SCHED;
            PG8_STAGE(PG8_SB(1, 1), b3 + hstep, voffB);
            PG8_WAIT_V(6); PG8_BAR; PG8_MMA(1, 1, At, B1); PG8_BAR;
            }
        }
        if constexpr (ALIGN_EPI) { if (wr == 0) PG8_BAR; }
        if constexpr (F8) { asm volatile("s_nop 15\n\ts_nop 15" ::: "memory"); }
        if constexpr (!Epi::AFTER_DRAIN) { E(acc, cur, wr, wc, fr, fq); S.done(cur); }
        if (!has_next) break;
#pragma unroll
        for (int a = 0; a < 2; ++a)
#pragma unroll
            for (int b = 0; b < 2; ++b)
#pragma unroll
                for (int m = 0; m < 4; ++m)
#pragma unroll
                    for (int n = 0; n < 2; ++n) acc[a][b][m][n] = (f32x4){0.f, 0.f, 0.f, 0.f};
        cur = nxt; cA = nA; cB = nB; ++ui;
        if constexpr (ALIGN_EPI) { if (wr == 1) PG8_BAR; }
    }
    PG8_WAIT_V(0);
    if constexpr (!ALIGN_EPI) { if (wr == 0) PG8_BAR; }
    PG8_BAR;
    if constexpr (Epi::AFTER_DRAIN) { E.fused(acc, cur, wr, wc, fr, fq, lds, wid, lane); S.done(cur); }
#undef PG8_SA
#undef PG8_SB
#undef PG8_STAGE
#undef PG8_LDA
#undef PG8_LDB
#undef PG8_MMA
#undef PG8_WAIT_V
#undef PG8_WAIT_L
#undef PG8_BAR
#undef PG8_SCHED
}
}

constexpr int D = 2048, NB = 4, SEQ_T = 4096, CTX_L = 256, DEPTH = 2;
constexpr int ML = NB * SEQ_T, MC = NB * CTX_L, MT = ML + MC;
constexpr int IN_DIM = 6656;
constexpr int OFF_CV = 0, OFF_CG = 512, OFF_Q = 1024, OFF_K = 2048, OFF_V = 3072, OFF_HQ = 4096, OFF_HI = 4608, OFF_HF = 5120, OFF_HB = 5632, OFF_HG = 6144;
constexpr int NE = 32, DE = 512;
constexpr int MOE_TILES_MAX = 168, P_MAX = MOE_TILES_MAX * 256;
constexpr float EPS = 1e-6f;
constexpr int NWAVES = 8, NTHREADS = 512;

constexpr size_t MiB = 1u << 20;
constexpr size_t WS_CTL = 0, CTL_ZERO_BYTES = 64 * 1024;
constexpr size_t WS_TAB = 2 * MiB;
constexpr size_t WS_WIN = 4 * MiB;
constexpr size_t WS_WOUT = 56 * MiB;
constexpr size_t WS_WE1 = 72 * MiB;
constexpr size_t WS_WE2 = 200 * MiB;
constexpr size_t WS_XL = 264 * MiB;
constexpr size_t WS_H = 400 * MiB;
constexpr size_t WS_U = 468 * MiB;
constexpr size_t WS_XS = WS_U;
constexpr size_t WS_ACT = WS_U + 168 * MiB;
constexpr size_t WS_CAT = 689 * MiB;
constexpr size_t WS_Y = 757 * MiB;
constexpr size_t WS_HGO = 893 * MiB;
constexpr size_t WS_VT = 961 * MiB;
constexpr size_t WS_SSTATE = 1014 * MiB;
constexpr size_t WS_RW = 1012 * MiB;
constexpr size_t WS_END = 1082 * MiB;
static_assert(WS_U + (size_t)MT * IN_DIM * 2 <= WS_CAT && WS_ACT + (size_t)P_MAX * 512 * 2 <= WS_CAT && WS_XS + (size_t)P_MAX * 2048 * 2 <= WS_ACT, "ws map");
constexpr int CW_BAR = 4096;
constexpr int CW_TICKET = 9216;
constexpr int CW_CNT = 8192;
constexpr int CW_MOD = 16384;
static_assert((CW_CNT + 128) * 4 <= (int)CTL_ZERO_BYTES && (CW_BAR + 3456) * 4 <= (int)CTL_ZERO_BYTES && (CW_MOD + DEPTH * 5 * 12288) * 4 <= (int)(2 * MiB), "CTL words");
constexpr size_t TB_TOKE = 0, TB_TOKW = 256 * 1024, TB_TOKP = 512 * 1024, TB_SDST = 768 * 1024, TB_SW = 1024 * 1024, TB_TILEE = 1280 * 1024, TB_NT = 1280 * 1024 + 2048, TB_RS = 1536 * 1024;

constexpr int RING_OFF = 0, RING_BYTES = 131072;
constexpr int LDSCTL_OFF = RING_BYTES, MISC_OFF = LDSCTL_OFF + 320;
constexpr int LDS_BYTES = 147456;

#define LAS __attribute__((address_space(3)))
#define GAS __attribute__((address_space(1)))
template <class T> __device__ __forceinline__ T* asglobal(T* p) { return (T*)(GAS T*)p; }
typedef unsigned short bf16;
typedef unsigned v4u __attribute__((ext_vector_type(4)));
typedef unsigned v2u __attribute__((ext_vector_type(2)));
typedef float f32x4 __attribute__((ext_vector_type(4)));
typedef short bf16x8 __attribute__((ext_vector_type(8)));
#define LDS_WAIT() asm volatile("s_waitcnt lgkmcnt(0)" ::: "memory")
#define VM_WAIT() asm volatile("s_waitcnt vmcnt(0)" ::: "memory")
__device__ __forceinline__ float bf2f(unsigned b16) { return __uint_as_float(b16 << 16); }
__device__ __forceinline__ float bflo(unsigned w) { return __uint_as_float(w << 16); }
__device__ __forceinline__ float bfhi(unsigned w) { return __uint_as_float(w & 0xffff0000u); }
__device__ __forceinline__ unsigned f2bf(float f) { unsigned u = __float_as_uint(f); return (u + 0x7fffu + ((u >> 16) & 1u)) >> 16; }
__device__ __forceinline__ unsigned pk2(float lo, float hi) { return pg8::cvt_pk_bf16(lo, hi); }
__device__ __forceinline__ f32x4 un4_fp8(int w) { const pg8::f32x2_t a = __builtin_amdgcn_cvt_pk_f32_fp8(w, false), b = __builtin_amdgcn_cvt_pk_f32_fp8(w, true); return (f32x4){a.x, a.y, b.x, b.y}; }
__device__ __forceinline__ float sigm(float x) { return __builtin_amdgcn_rcpf(1.f + __expf(-x)); }
__device__ __forceinline__ float silu(float x) { return x * __builtin_amdgcn_rcpf(1.f + __expf(-x)); }
__device__ __forceinline__ float fast_log(float x) { return __builtin_amdgcn_logf(x) * 0.69314718056f; }
__device__ __forceinline__ float wave_sum(float v) {
#pragma unroll
    for (int o = 1; o < 64; o <<= 1) v += __shfl_xor(v, o);
    return v;
}
__device__ __forceinline__ float wave_max(float v) {
#pragma unroll
    for (int o = 1; o < 64; o <<= 1) v = fmaxf(v, __shfl_xor(v, o));
    return v;
}

#define XB_TMO      128
#define XB_XCNT(j)  (256  + 64 * (j))
#define XB_XSUB(j)  (1280 + 64 * (j))
#define XB_XGEN(j)  (2304 + 64 * (j))
#define XB_TOP      3328
#define XB_TOPGEN   3392
#define XCD_BAR_WORDS 3456
#define XB_SPIN_CAP (1u << 18)

__device__ __forceinline__ unsigned xb_ld(unsigned* p)              { return __hip_atomic_load(p, __ATOMIC_RELAXED, __HIP_MEMORY_SCOPE_AGENT); }
__device__ __forceinline__ unsigned xb_add(unsigned* p, unsigned v) { return __hip_atomic_fetch_add(p, v, __ATOMIC_RELAXED, __HIP_MEMORY_SCOPE_AGENT); }
__device__ __forceinline__ unsigned xb_xcc_id() { return (unsigned)__builtin_amdgcn_s_getreg((3 << 11) | 20) & 0xFu; }
#define XB_SPIN(cond, bar) do { unsigned _sp = 0; while (cond) { __builtin_amdgcn_s_sleep(1); \
    if ((++_sp & 255u) == 0u) { if (xb_ld(&(bar)[XB_TMO])) break; if (_sp > XB_SPIN_CAP) { atomicAdd(&(bar)[XB_TMO], 1u); break; } } } } while (0)

struct XcdBarrier {
    unsigned* bar; unsigned x;
    volatile LAS unsigned* st;
};

__device__ __forceinline__ XcdBarrier xcd_barrier_post(unsigned* bar, volatile LAS unsigned* st) {
    XcdBarrier b; b.bar = bar; b.x = xb_xcc_id(); b.st = st;
    if (threadIdx.x == 0) (void)xb_add(&bar[XB_XCNT(b.x)], 1u);
    return b;
}
__device__ __forceinline__ void xcd_barrier_complete(unsigned* bar, unsigned x, unsigned& nloc, unsigned& nx) {
    const unsigned G = gridDim.x * gridDim.y * gridDim.z;
    unsigned sum, cnt, mine, sp = 0u;
    for (;;) {
        sum = 0u; cnt = 0u; mine = 0u;
#pragma unroll
        for (unsigned j = 0; j < 16; ++j) { const unsigned c = xb_ld(&bar[XB_XCNT(j)]); sum += c; cnt += (c > 0u) ? 1u : 0u; mine = (j == x) ? c : mine; }
        if (sum == G) break;
        __builtin_amdgcn_s_sleep(1);
        if ((++sp & 255u) == 0u) { if (xb_ld(&bar[XB_TMO])) break; if (sp > XB_SPIN_CAP) { atomicAdd(&bar[XB_TMO], 1u); break; } }
    }
    nloc = mine > 0u ? mine : 1u; nx = cnt > 0u ? cnt : 1u;
}

__device__ __forceinline__ void xcd_barrier(const XcdBarrier& b) {
    asm volatile("s_waitcnt vmcnt(0)" ::: "memory");
    __syncthreads();
    if (threadIdx.x == 0) {
        unsigned* bar = b.bar;
        __builtin_amdgcn_s_waitcnt(0);
        unsigned nloc = b.st[0], nx = b.st[1];
        if (nloc == 0u) { xcd_barrier_complete(bar, b.x, nloc, nx); b.st[0] = nloc; b.st[1] = nx; }
        const unsigned old = xb_add(&bar[XB_XSUB(b.x)], 1u);
        const unsigned gen = old / nloc;
        if (old + 1u == (gen + 1u) * nloc) {
            __builtin_amdgcn_fence(__ATOMIC_RELEASE, "agent");
            asm volatile("s_waitcnt vmcnt(0)" ::: "memory");
            const unsigned og = xb_add(&bar[XB_TOP], 1u);
            const unsigned tg = og / nx;
            if (og + 1u == (tg + 1u) * nx) xb_add(&bar[XB_TOPGEN], 1u);
            else XB_SPIN(xb_ld(&bar[XB_TOPGEN]) == tg, bar);
            __builtin_amdgcn_fence(__ATOMIC_ACQUIRE, "agent");
            xb_add(&bar[XB_XGEN(b.x)], 1u);
            asm volatile("s_waitcnt vmcnt(0)" ::: "memory");
        } else {
            XB_SPIN(xb_ld(&bar[XB_XGEN(b.x)]) == gen, bar);
            __builtin_amdgcn_fence(__ATOMIC_ACQUIRE, "agent");
            asm volatile("s_waitcnt vmcnt(0)" ::: "memory");
        }
    }
    __syncthreads();
}

struct Args { const float* in[25]; float* out; unsigned char* ws; int ph_lo, ph_hi; };
enum { I_X = 0, I_C, I_CTX, I_CCTX, I_WADA, I_BADA, I_GMIX, I_GFFN, I_WIN, I_CONVW, I_CONVB, I_CLNG, I_CLNB, I_RPB, I_HLB, I_HNG, I_WOUT, I_WRG, I_BRG, I_WRE, I_BRE, I_WEG, I_WEU, I_WED, I_GFIN };

struct Ctx {
    LAS unsigned char* lds;
    int tid, lane, wave, G, gw, NGW;
    unsigned char* ws;
    float* mod;
};
constexpr int ARGS_OFF = MISC_OFF + 128, TILE_LDS_OFF = ARGS_OFF + 256;
__device__ __forceinline__ const float* argp(const Ctx& C, int i) {
    int o = ARGS_OFF + 8 * i; asm volatile("" : "+v"(o));
    const LAS unsigned* t = (const LAS unsigned*)(C.lds + o);
    const unsigned lo = __builtin_amdgcn_readfirstlane(t[0]), hi = __builtin_amdgcn_readfirstlane(t[1]);
    return (const float*)(C.ws + (((unsigned long long)hi << 32) | lo));
}
#define AIN(i) argp(C, (i))
__device__ __forceinline__ const float* modp(const Ctx& C, int l, int r, int chunk) { return C.mod + (size_t)(l * 5 + r) * 12288 + chunk * 2048; }

__device__ __forceinline__ void ph_mod(const Args& a, const Ctx& C) {
    const float* c = AIN(I_C); const float* cctx = AIN(I_CCTX); const float* w_ada = AIN(I_WADA); const float* b_ada = AIN(I_BADA);
    LAS float* red = (LAS float*)(C.lds + RING_OFF);
    for (int unit = blockIdx.x; unit < DEPTH * 96; unit += C.G) {
        const int l = unit / 96, nc = unit % 96;
        const int n0 = nc * 128 + C.lane * 2, k0 = C.wave * 256;
        float acc[5][2];
#pragma unroll
        for (int r = 0; r < 5; ++r) { acc[r][0] = 0.f; acc[r][1] = 0.f; }
        const float* wp = w_ada + ((size_t)l * 2048 + k0) * 12288 + n0;
        for (int kb = 0; kb < 256; kb += 16) {
            float2 w[16];
#pragma unroll
            for (int u = 0; u < 16; ++u) w[u] = *(const float2*)(wp + (size_t)(kb + u) * 12288);
            __builtin_amdgcn_sched_barrier(0);
#pragma unroll
            for (int u = 0; u < 16; ++u) { const int k = kb + u; float s[5];
#pragma unroll
                for (int r = 0; r < 4; ++r) s[r] = silu(c[r * 2048 + k0 + k]);
                s[4] = silu(cctx[k0 + k]);
#pragma unroll
                for (int r = 0; r < 5; ++r) { acc[r][0] += s[r] * w[u].x; acc[r][1] += s[r] * w[u].y; } }
        }
#pragma unroll
        for (int r = 0; r < 5; ++r) { red[(C.wave * 5 + r) * 128 + C.lane * 2] = acc[r][0]; red[(C.wave * 5 + r) * 128 + C.lane * 2 + 1] = acc[r][1]; }
        __syncthreads();
        for (int idx = C.tid; idx < 5 * 128; idx += NTHREADS) { const int r = idx >> 7, col = idx & 127; float s = b_ada[(size_t)l * 12288 + nc * 128 + col];
#pragma unroll
            for (int w = 0; w < 8; ++w) s += red[(w * 5 + r) * 128 + col];
            C.mod[(size_t)(l * 5 + r) * 12288 + nc * 128 + col] = s; }
        __syncthreads();
    }
}

constexpr float CAT_NA_SC = 8.f;
constexpr int CONV_SCR = 8704;
struct TrItem { const float* W; int N, k0, n0; bf16* WT; int K, drow0; float f8scale; };
__device__ __forceinline__ void tr_load(const TrItem& t, f32x4 (&v)[8], int lane) {
    const int kr = lane >> 3, nc = lane & 7;
#pragma unroll
    for (int i = 0; i < 8; ++i) v[i] = *(const f32x4*)(t.W + (size_t)(t.k0 + 8 * i + kr) * t.N + t.n0 + 4 * nc);
}
__device__ __forceinline__ void tr_store(const TrItem& t, const f32x4 (&v)[8], LAS float* scr, int lane) {
    const int kr = lane >> 3, nc = lane & 7;
    LDS_WAIT(); asm volatile("" ::: "memory");
#pragma unroll
    for (int i = 0; i < 8; ++i) { LAS float* d = scr + (8 * i + kr) * 33 + 4 * nc; d[0] = v[i].x; d[1] = v[i].y; d[2] = v[i].z; d[3] = v[i].w; }
    LDS_WAIT(); asm volatile("" ::: "memory");
    const int c = lane & 7;
    if (t.f8scale != 0.f) { const float sc = t.f8scale; unsigned char* W8 = (unsigned char*)t.WT;
#pragma unroll
        for (int j = 0; j < 4; ++j) { const int n = (lane >> 3) + 8 * j; const LAS float* s = scr + (8 * c) * 33 + n;
            v2u o; o.x = pg8::cvt4_fp8(s[0 * 33] * sc, s[1 * 33] * sc, s[2 * 33] * sc, s[3 * 33] * sc); o.y = pg8::cvt4_fp8(s[4 * 33] * sc, s[5 * 33] * sc, s[6 * 33] * sc, s[7 * 33] * sc);
            *(v2u*)(W8 + (size_t)(t.drow0 + n) * t.K + t.k0 + 8 * c) = o; }
        return; }
#pragma unroll
    for (int j = 0; j < 4; ++j) { const int n = (lane >> 3) + 8 * j; const LAS float* s = scr + (8 * c) * 33 + n;
        v4u o; o.x = pk2(s[0 * 33], s[1 * 33]); o.y = pk2(s[2 * 33], s[3 * 33]); o.z = pk2(s[4 * 33], s[5 * 33]); o.w = pk2(s[6 * 33], s[7 * 33]);
        *(v4u*)(t.WT + (size_t)(t.drow0 + n) * t.K + t.k0 + 8 * c) = o; }
}
__device__ __forceinline__ TrItem dense_item(const Ctx& C, int it) {
    constexpr int I_IN = 32 * 208, I_OUT = 32 * 64;
    const int l = it / (I_IN + I_OUT); int r = it % (I_IN + I_OUT); TrItem t; t.f8scale = 0.f;
    if (r < I_IN) { const int kb = r / 208, nb = r % 208;
        const int n0 = 32 * nb, np = n0 & 511;
        t.W = AIN(I_WIN) + (size_t)l * 2048 * IN_DIM; t.N = IN_DIM; t.k0 = 64 * kb; t.n0 = n0; t.WT = (bf16*)(C.ws + WS_WIN) + (size_t)l * IN_DIM * 2048; t.K = 2048;
        t.drow0 = n0 < 1024 ? 256 * (np >> 7) + (np & 127) + (n0 >= 512 ? 128 : 0) : n0; }
    else { r -= I_IN; const int kb = r / 64, nb = r % 64;
        t.W = AIN(I_WOUT) + (size_t)l * 2048 * 2048; t.N = 2048; t.k0 = 64 * kb; t.n0 = 32 * nb; t.WT = (bf16*)(C.ws + WS_WOUT + (size_t)l * 2048 * 2048); t.K = 2048; t.drow0 = 32 * nb;
        t.f8scale = (64 * kb >= 512 && 64 * kb < 1536) ? pg8::F8_SC1 / CAT_NA_SC : pg8::F8_SC1; }
    return t;
}
__device__ __forceinline__ TrItem expert_item(const Ctx& C, int l, int it) {
    const int e = it / 1536; int r = it % 1536; const size_t eo = (size_t)(l * NE + e) * 2048 * 512; TrItem t;
    if (r < 1024) { const int up = r >= 512; r &= 511; const int kb = r / 16, nb = r % 16, n0 = 32 * nb;
        t.W = (up ? AIN(I_WEU) : AIN(I_WEG)) + eo; t.N = 512; t.k0 = 64 * kb; t.n0 = n0; t.WT = (bf16*)(C.ws + WS_WE1 + (size_t)e * 1024 * 2048); t.K = 2048; t.drow0 = 256 * (n0 >> 7) + (n0 & 127) + (up ? 128 : 0); t.f8scale = pg8::F8_SC1; }
    else { r -= 1024; const int kb = r / 64, nb = r % 64;
        t.W = AIN(I_WED) + eo; t.N = 2048; t.k0 = 64 * kb; t.n0 = 32 * nb; t.WT = (bf16*)(C.ws + WS_WE2 + (size_t)e * 2048 * 512); t.K = 512; t.drow0 = 32 * nb; t.f8scale = pg8::F8_SC2; }
    return t;
}
#define CONV_PASS(NITEMS, DECODE) do { \
        const int nmod_ = skew ? min(C.G, DEPTH * 96) : 0, nsl_ = skew ? ((int)blockIdx.x < nmod_ ? 3 : 4) : 1, TS_ = skew ? nmod_ * NWAVES * 3 + (C.G - nmod_) * NWAVES * 4 : C.NGW; \
        const int sb_ = skew ? ((int)blockIdx.x < nmod_ ? C.gw * 3 : nmod_ * NWAVES * 3 + (C.gw - nmod_ * NWAVES) * 4) : C.gw; \
        int k_ = 0, it_ = sb_; f32x4 va_[8], vb_[8]; TrItem ta_, tb_; \
        if (it_ < (NITEMS)) { ta_ = DECODE(it_); tr_load(ta_, va_, C.lane); } \
        while (it_ < (NITEMS)) { ++k_; const int in_ = sb_ + (k_ % nsl_) + (k_ / nsl_) * TS_; \
            if (in_ < (NITEMS)) { tb_ = DECODE(in_); tr_load(tb_, vb_, C.lane); } \
            __builtin_amdgcn_sched_barrier(0); \
            tr_store(ta_, va_, scr, C.lane); \
            _Pragma("unroll") for (int i_ = 0; i_ < 8; ++i_) va_[i_] = vb_[i_]; ta_ = tb_; it_ = in_; \
            __builtin_amdgcn_sched_barrier(0); } } while (0)
__device__ __forceinline__ void ph_conv_dense_w(const Args& a, const Ctx& C) {
    LAS float* scr = (LAS float*)(C.lds + RING_OFF + C.wave * CONV_SCR); const bool skew = true;
#define DEC_DENSE(i) dense_item(C, (i))
    CONV_PASS(DEPTH * (32 * 208 + 32 * 64), DEC_DENSE);
#undef DEC_DENSE
}
__device__ __forceinline__ void ph_conv_expert_w(const Args& a, const Ctx& C, int l, bool skew) {
    LAS float* scr = (LAS float*)(C.lds + RING_OFF + C.wave * CONV_SCR);
#define DEC_EXP(i) expert_item(C, l, (i))
    CONV_PASS(NE * 1536, DEC_EXP);
#undef DEC_EXP
}
#undef CONV_PASS

constexpr int TBL_OFF = RING_OFF + NWAVES * CONV_SCR;
static_assert(TBL_OFF + 6 * 8192 <= RING_OFF + RING_BYTES, "LDS tables");
__device__ __forceinline__ int stream_nslots(const Ctx& C) { const int wpb = C.G >> 2, rpw = (SEQ_T + wpb - 1) / wpb; return (rpw + NWAVES - 1) / NWAVES + (MC + C.NGW - 1) / C.NGW; }
__device__ __forceinline__ int stream_row(const Ctx& C, int k, int nrows) {
    const int wpb = C.G >> 2, rpw = (SEQ_T + wpb - 1) / wpb, nl = (rpw + NWAVES - 1) / NWAVES, b = (int)blockIdx.x / wpb, wi = (int)blockIdx.x % wpb;
    if (k < nl) { const int q = C.wave + NWAVES * k, t = wi * rpw + q; return (b < NB && q < rpw && t < SEQ_T) ? b * SEQ_T + t : -1; }
    const int c = (k - nl) * C.NGW + C.wave * C.G + (int)blockIdx.x; return (c < MC && ML + c < nrows) ? ML + c : -1;
}
__device__ __forceinline__ int stream_batch(const Ctx& C) { const int b = (int)blockIdx.x / (C.G >> 2); return b < NB ? b : NB - 1; }

__device__ __forceinline__ void ph_norm1_tables(const Ctx& C, int l) {
    LAS float* T = (LAS float*)(C.lds + TBL_OFF); const float* gmix = AIN(I_GMIX) + (size_t)l * D; const int rb = stream_batch(C);
    for (int i = C.tid; i < 2 * 2048; i += NTHREADS) { const int set = i >> 11, col = i & 2047, r = set ? 4 : rb;
        T[(set * 3 + 0) * 2048 + col] = gmix[col] * (1.f + modp(C, l, r, 1)[col]); T[(set * 3 + 1) * 2048 + col] = modp(C, l, r, 0)[col];
        T[(set * 3 + 2) * 2048 + col] = l > 0 ? modp(C, l - 1, r, 5)[col] * (1.f / pg8::F8_SCY) : 0.f; }
}
__device__ __forceinline__ void ph_norm1(const Args& a, const Ctx& C, int l) {
    float* XL = (float*)(C.ws + WS_XL); bf16* H = (bf16*)(C.ws + WS_H); const unsigned char* Y = (const unsigned char*)(C.ws + WS_Y);
    const LAS float* T = (const LAS float*)(C.lds + TBL_OFF);
    f32x4 va[8], vb[8]; int pa[8], qa[8], pb[8], qb[8];
#pragma unroll
    for (int j = 0; j < 8; ++j) { pa[j] = 0; qa[j] = 0; pb[j] = 0; qb[j] = 0; }
#define N1_LOAD(V, P, Q, rw) do { const int rw_ = (rw); \
        const float* src_ = (l == 0) ? (rw_ < ML ? AIN(I_X) + (size_t)rw_ * D : AIN(I_CTX) + (size_t)(rw_ - ML) * D) : XL + (size_t)rw_ * D; \
        _Pragma("unroll") for (int j = 0; j < 8; ++j) V[j] = *(const f32x4*)(src_ + C.lane * 4 + 256 * j); \
        if (l > 0) { const unsigned char* y0_ = Y + (size_t)(2 * rw_) * D; \
            _Pragma("unroll") for (int j = 0; j < 8; ++j) { P[j] = *(const int*)(y0_ + C.lane * 4 + 256 * j); Q[j] = *(const int*)(y0_ + D + C.lane * 4 + 256 * j); } } } while (0)
    const int NK = stream_nslots(C);
    int rowa = stream_row(C, 0, MT);
    if (rowa >= 0) N1_LOAD(va, pa, qa, rowa);
    for (int k = 0; k < NK; ++k) {
        const int rowb = k + 1 < NK ? stream_row(C, k + 1, MT) : -1;
        if (rowb >= 0) N1_LOAD(vb, pb, qb, rowb);
        __builtin_amdgcn_sched_barrier(0);
        if (rowa >= 0) {
            const LAS float* Ts = T + (rowa < ML ? 0 : 3 * 2048) + C.lane * 4;
            if (l > 0) {
#pragma unroll
                for (int j = 0; j < 8; ++j) { const f32x4 g = *(const LAS f32x4*)(Ts + 2 * 2048 + 256 * j);
                    va[j] = va[j] + g * (un4_fp8(pa[j]) + un4_fp8(qa[j]));
                    *(f32x4*)(XL + (size_t)rowa * D + C.lane * 4 + 256 * j) = va[j]; }
            }
            float ss = 0.f;
#pragma unroll
            for (int j = 0; j < 8; ++j) ss += (va[j].x * va[j].x + va[j].y * va[j].y) + (va[j].z * va[j].z + va[j].w * va[j].w);
            const float rs = rsqrtf(wave_sum(ss) * (1.f / D) + EPS);
#pragma unroll
            for (int j = 0; j < 8; ++j) { const f32x4 ga = *(const LAS f32x4*)(Ts + 256 * j), sh = *(const LAS f32x4*)(Ts + 2048 + 256 * j);
                const f32x4 h = va[j] * rs * ga + sh; v2u o; o.x = pk2(h.x, h.y); o.y = pk2(h.z, h.w); *(v2u*)(H + (size_t)rowa * D + C.lane * 4 + 256 * j) = o; }
        }
#pragma unroll
        for (int j = 0; j < 8; ++j) { va[j] = vb[j]; pa[j] = pb[j]; qa[j] = qb[j]; }
        rowa = rowb;
        __builtin_amdgcn_sched_barrier(0);
    }
#undef N1_LOAD
}

constexpr size_t WS_UST = WS_Y;
constexpr size_t WS_QB = WS_H;
constexpr size_t WS_UD = WS_H + 34 * MiB;
constexpr int HG_UNITS = 32 * 68;
__device__ __forceinline__ float hgrn_lb(const Ctx& C, int l, int dir, int idx) {
    if (l == 0) return 0.f;
    const float* hl = AIN(I_HLB); const float a0 = hl[(0 * 2 + dir) * 512 + idx], a1 = hl[(1 * 2 + dir) * 512 + idx]; return 1.f / (1.f + __expf(a0 - a1));
}
__device__ __forceinline__ void ph_hgrn_a(const Args& a, const Ctx& C, int l) {
    const bf16* U = (const bf16*)(C.ws + WS_U); const bf16* VT = (const bf16*)(C.ws + WS_VT); bf16* HGO = (bf16*)(C.ws + WS_HGO);
    bf16* UST = (bf16*)(C.ws + WS_UST); bf16* QB = (bf16*)(C.ws + WS_QB); float* UD = (float*)(C.ws + WS_UD);
    constexpr int QS = 272, KS = 144;
    LAS unsigned char* Qt = C.lds + RING_OFF; LAS unsigned char* Kt = Qt + 64 * QS; LAS unsigned char* KbT = Kt + 64 * QS; LAS float* tot = (LAS float*)(KbT + 128 * KS);
    LAS unsigned char* Qbl = (LAS unsigned char*)(tot + 512);
    const int tid = C.tid, k = tid & 127, seg = tid >> 7, w = C.wave, j16 = C.lane & 15, g = C.lane >> 4;
    const int lr = tid >> 4, lc = (tid & 15) * 8;
    v4u rz0, rz1, rq0, rq1;
#define HG_LOADRAW(un) do { const int seq_ = (un) / 68, mc_ = (un) % 68, b_ = seq_ >> 3, h_ = (seq_ >> 1) & 3, dir_ = seq_ & 1; \
        const int tb_ = mc_ < 4 ? ML + b_ * CTX_L + 64 * mc_ : b_ * SEQ_T + 64 * (mc_ - 4); const int zo_ = dir_ ? OFF_HB : OFF_HF; \
        const bf16* ub_ = U + (size_t)tb_ * IN_DIM + h_ * 128 + lc; \
        rz0 = *(const v4u*)(ub_ + (size_t)lr * IN_DIM + zo_); rz1 = *(const v4u*)(ub_ + (size_t)(lr + 32) * IN_DIM + zo_); \
        rq0 = *(const v4u*)(ub_ + (size_t)lr * IN_DIM + OFF_HQ); rq1 = *(const v4u*)(ub_ + (size_t)(lr + 32) * IN_DIM + OFF_HQ); } while (0)
    if ((int)blockIdx.x < HG_UNITS) HG_LOADRAW(blockIdx.x);
    for (int unit = blockIdx.x; unit < HG_UNITS; unit += C.G) {
        const int seq = unit / 68, mc = unit % 68, b = seq >> 3, h = (seq >> 1) & 3, dir = seq & 1;
        const int tokbase = mc < 4 ? ML + b * CTX_L + 64 * mc : b * SEQ_T + 64 * (mc - 4);
        const float lb = hgrn_lb(C, l, dir, h * 128 + k);
        const int tq = w & 3, vh = w >> 2, pq = 16 * tq + j16;
        const bf16* vrow = VT + (size_t)(1024 + h * 128 + j16) * MT + tokbase + 8 * g;
        bf16x8 vu[8][2];
#pragma unroll
        for (int vt = 0; vt < 8; ++vt) { vu[vt][0] = *(const bf16x8*)(vrow + (size_t)(16 * vt) * MT); vu[vt][1] = *(const bf16x8*)(vrow + (size_t)(16 * vt) * MT + 32); }
        *(LAS v4u*)(Kt + lr * QS + 2 * lc) = rz0; *(LAS v4u*)(Kt + (lr + 32) * QS + 2 * lc) = rz1; *(LAS v4u*)(Qt + lr * QS + 2 * lc) = rq0; *(LAS v4u*)(Qt + (lr + 32) * QS + 2 * lc) = rq1;
        __syncthreads();
        float cs[16], sq[16], kk[16]; float run = 0.f;
        const int pstep = dir ? -QS : QS, pa0 = (dir ? 63 - 16 * seg : 16 * seg) * QS + 2 * k;
#pragma unroll
        for (int i = 0; i < 16; ++i) { const int po = pa0 + i * pstep;
            const float zv = bf2f(*(const LAS unsigned short*)(Kt + po)), qv = bf2f(*(const LAS unsigned short*)(Qt + po));
            const float f = lb + (1.f - lb) * sigm(zv); run += __builtin_amdgcn_logf(f);     cs[i] = run; kk[i] = 1.f - f; sq[i] = silu(qv); }
        tot[seg * 128 + k] = run;
        __syncthreads();
        const float t0 = tot[k], t1 = tot[128 + k], t2 = tot[256 + k], t3 = tot[384 + k];
        const float off = (seg > 0 ? t0 : 0.f) + (seg > 1 ? t1 : 0.f) + (seg > 2 ? t2 : 0.f), bmid = t0 + t1, blast = (t0 + t1) + (t2 + t3);
        const float ebm = __builtin_amdgcn_exp2f(bmid), elm = __builtin_amdgcn_exp2f(blast - bmid);
        float kb[16];
#pragma unroll
        for (int i = 0; i < 16; ++i) { const int po = pa0 + i * pstep; const float bb = off + cs[i];
            const float qt = sq[i] * __builtin_amdgcn_exp2f(fminf(bb - bmid, 115.f)), kt = kk[i] * __builtin_amdgcn_exp2f(fminf(bmid - bb, 115.f));
            const unsigned qq = pk2(qt, qt * ebm), kq = pk2(kt, kt);
            *(LAS unsigned short*)(Qt + po) = (unsigned short)qq; *(LAS unsigned short*)(Kt + po) = (unsigned short)kq;
            *(LAS unsigned short*)(Qbl + po) = (unsigned short)(qq >> 16); kb[i] = kt * elm; }
        {
            v4u w0, w1;
            if (!dir) { w0.x = pk2(kb[0], kb[1]); w0.y = pk2(kb[2], kb[3]); w0.z = pk2(kb[4], kb[5]); w0.w = pk2(kb[6], kb[7]); w1.x = pk2(kb[8], kb[9]); w1.y = pk2(kb[10], kb[11]); w1.z = pk2(kb[12], kb[13]); w1.w = pk2(kb[14], kb[15]); }
            else { w0.x = pk2(kb[15], kb[14]); w0.y = pk2(kb[13], kb[12]); w0.z = pk2(kb[11], kb[10]); w0.w = pk2(kb[9], kb[8]); w1.x = pk2(kb[7], kb[6]); w1.y = pk2(kb[5], kb[4]); w1.z = pk2(kb[3], kb[2]); w1.w = pk2(kb[1], kb[0]); }
            const int p0 = dir ? 48 - 16 * seg : 16 * seg;
            *(LAS v4u*)(KbT + k * KS + 2 * p0) = w0; *(LAS v4u*)(KbT + k * KS + 2 * p0 + 16) = w1; }
        if (seg == 0) UD[(size_t)unit * 128 + k] = __builtin_amdgcn_exp2f(blast);
        __builtin_amdgcn_sched_barrier(0);
        __syncthreads();
        if (unit + C.G < HG_UNITS) HG_LOADRAW(unit + C.G);
        __builtin_amdgcn_sched_barrier(0);
        { bf16* qb = QB + ((size_t)dir * MT + tokbase) * 512 + h * 128 + lc;
            *(v4u*)(qb + (size_t)lr * 512) = *(const LAS v4u*)(Qbl + lr * QS + 2 * lc); *(v4u*)(qb + (size_t)(lr + 32) * 512) = *(const LAS v4u*)(Qbl + (lr + 32) * QS + 2 * lc); }
        { bf16x8 pf[2];
#pragma unroll
            for (int sg = 0; sg < 2; ++sg) { f32x4 a0 = {0.f, 0.f, 0.f, 0.f}, a1 = {0.f, 0.f, 0.f, 0.f};
                const int prow = 32 * sg + 8 * (j16 >> 2) + (j16 & 3);
#pragma unroll
                for (int ks = 0; ks < 4; ++ks) { const bf16x8 kf0 = *(const LAS bf16x8*)(Kt + prow * QS + 2 * (32 * ks + 8 * g)), kf1 = *(const LAS bf16x8*)(Kt + (prow + 4) * QS + 2 * (32 * ks + 8 * g));
                    const bf16x8 qf = *(const LAS bf16x8*)(Qt + pq * QS + 2 * (32 * ks + 8 * g));
                    a0 = __builtin_amdgcn_mfma_f32_16x16x32_bf16(kf0, qf, a0, 0, 0, 0); a1 = __builtin_amdgcn_mfma_f32_16x16x32_bf16(kf1, qf, a1, 0, 0, 0); }
#pragma unroll
                for (int t = 0; t < 4; ++t) { const int pk0 = 32 * sg + 8 * g + t, pk1 = pk0 + 4;
                    const bool ok0 = dir ? (pk0 >= pq) : (pk0 <= pq), ok1 = dir ? (pk1 >= pq) : (pk1 <= pq); a0[t] = ok0 ? a0[t] : 0.f; a1[t] = ok1 ? a1[t] : 0.f; }
                v4u pw; pw.x = pg8::cvt_pk_bf16(a0[0], a0[1]); pw.y = pg8::cvt_pk_bf16(a0[2], a0[3]); pw.z = pg8::cvt_pk_bf16(a1[0], a1[1]); pw.w = pg8::cvt_pk_bf16(a1[2], a1[3]);
                pf[sg] = __builtin_bit_cast(bf16x8, pw); }
#pragma unroll
            for (int vi = 0; vi < 4; ++vi) { const int vt = 4 * vh + vi; f32x4 o = {0.f, 0.f, 0.f, 0.f};
                const bf16x8 v0 = vh ? vu[4 + vi][0] : vu[vi][0], v1 = vh ? vu[4 + vi][1] : vu[vi][1];
                o = __builtin_amdgcn_mfma_f32_16x16x32_bf16(v0, pf[0], o, 0, 0, 0); o = __builtin_amdgcn_mfma_f32_16x16x32_bf16(v1, pf[1], o, 0, 0, 0);
                v2u ow; ow.x = pg8::cvt_pk_bf16(o[0], o[1]); ow.y = pg8::cvt_pk_bf16(o[2], o[3]); *(v2u*)(HGO + ((size_t)dir * MT + tokbase + pq) * 512 + h * 128 + 16 * vt + 4 * g) = ow; }
        }
        { const bf16x8 kb0 = *(const LAS bf16x8*)(KbT + (16 * w + j16) * KS + 2 * (8 * g)), kb1 = *(const LAS bf16x8*)(KbT + (16 * w + j16) * KS + 2 * (32 + 8 * g));
#pragma unroll
            for (int vt = 0; vt < 8; ++vt) { f32x4 u = {0.f, 0.f, 0.f, 0.f};
                u = __builtin_amdgcn_mfma_f32_16x16x32_bf16(kb0, vu[vt][0], u, 0, 0, 0); u = __builtin_amdgcn_mfma_f32_16x16x32_bf16(kb1, vu[vt][1], u, 0, 0, 0);
                v2u uw; uw.x = pg8::cvt_pk_bf16(u[0], u[1]); uw.y = pg8::cvt_pk_bf16(u[2], u[3]); *(v2u*)(UST + ((size_t)unit * 128 + 16 * vt + j16) * 128 + 16 * w + 4 * g) = uw; }
        }
        __syncthreads();
    }
#undef HG_LOADRAW
}
__device__ __forceinline__ void ph_hgrn_scan(const Ctx& C) {
    const bf16* UST = (const bf16*)(C.ws + WS_UST); const float* UD = (const float*)(C.ws + WS_UD); bf16* SST = (bf16*)(C.ws + WS_SSTATE);
    for (int e = C.gw * 64 + C.lane; e < 32 * 4096; e += C.NGW * 64) {
        const int seq = e >> 12, vk = e & 4095, v = vk >> 5, k4 = (vk & 31) * 4, dir = seq & 1;
        f32x4 S = {0.f, 0.f, 0.f, 0.f}, da[4], db[4]; v2u ua[4], ub[4];
#define HG_MC(step) (dir ? ((step) < 4 ? 3 - (step) : 71 - (step)) : (step))
#pragma unroll
        for (int i = 0; i < 4; ++i) { const size_t unit = (size_t)seq * 68 + HG_MC(i); ua[i] = *(const v2u*)(UST + (unit * 128 + v) * 128 + k4); da[i] = *(const f32x4*)(UD + unit * 128 + k4); }
        for (int bi = 0; bi < 17; ++bi) {
            const int nb = bi + 1 < 17 ? bi + 1 : bi;
#pragma unroll
            for (int i = 0; i < 4; ++i) { const size_t unit = (size_t)seq * 68 + HG_MC(4 * nb + i); ub[i] = *(const v2u*)(UST + (unit * 128 + v) * 128 + k4); db[i] = *(const f32x4*)(UD + unit * 128 + k4); }
            __builtin_amdgcn_sched_barrier(0);
#pragma unroll
            for (int i = 0; i < 4; ++i) { const size_t unit = (size_t)seq * 68 + HG_MC(4 * bi + i);
                v2u w; w.x = pk2(S.x, S.y); w.y = pk2(S.z, S.w); *(v2u*)(SST + (unit * 128 + v) * 128 + k4) = w;
                const f32x4 uf = {bflo(ua[i].x), bfhi(ua[i].x), bflo(ua[i].y), bfhi(ua[i].y)}; S = da[i] * S + uf; }
#pragma unroll
            for (int i = 0; i < 4; ++i) { ua[i] = ub[i]; da[i] = db[i]; }
            __builtin_amdgcn_sched_barrier(0);
        }
#undef HG_MC
    }
}
constexpr int RO_RED_OFF = LDSCTL_OFF + 4096;
__device__ __forceinline__ void ph_hgrn_readout(const Args& a, const Ctx& C, int l, bool last) {
    const bf16* U = (const bf16*)(C.ws + WS_U); const bf16* HGO = (const bf16*)(C.ws + WS_HGO); unsigned char* CAT = (unsigned char*)(C.ws + WS_CAT);
    const bf16* SST = (const bf16*)(C.ws + WS_SSTATE); const bf16* QB = (const bf16*)(C.ws + WS_QB);
    const float* ng = AIN(I_HNG) + (size_t)l * 512;
    const int j16 = C.lane & 15, g = C.lane >> 4, tq = C.wave & 3, vh = C.wave >> 2;
    const int nch = last ? 16 * 64 : 16 * 68;
    LAS unsigned char* ring = C.lds + RING_OFF; LAS float* red = (LAS float*)(C.lds + RO_RED_OFF);
#define RO_DEC(ch, bh_, mc_) const int bh_ = last ? (ch) >> 6 : (ch) / 68, mc_ = last ? 4 + ((ch) & 63) : (ch) % 68
#define RO_DMA(ch, buf) do { RO_DEC(ch, bh_, mc_); _Pragma("unroll") for (int dir = 0; dir < 2; ++dir) { const bf16* src_ = SST + ((size_t)(bh_ * 2 + dir) * 68 + mc_) * 16384; \
        _Pragma("unroll") for (int i = 0; i < 4; ++i) { const int I_ = C.wave * 4 + i, row_ = 4 * I_ + g, ck_ = j16 ^ (row_ & 15); \
            __builtin_amdgcn_global_load_lds((const unsigned*)(src_ + row_ * 128 + ck_ * 8), (LAS unsigned*)(ring + (buf) * 65536 + dir * 32768 + I_ * 1024), 16, 0, 0); } } } while (0)
#define RO_REGS(ch, QF, HF, HB, GR, NN, TOK) do { RO_DEC(ch, bh_, mc_); const int b_ = bh_ >> 2, h_ = bh_ & 3; TOK = (mc_ < 4 ? ML + b_ * CTX_L + 64 * mc_ : b_ * SEQ_T + 64 * (mc_ - 4)) + 16 * tq + j16; \
        _Pragma("unroll") for (int dir = 0; dir < 2; ++dir) { const bf16* qp_ = QB + ((size_t)dir * MT + TOK) * 512 + h_ * 128 + 8 * g; _Pragma("unroll") for (int ks = 0; ks < 4; ++ks) QF[dir][ks] = *(const bf16x8*)(qp_ + 32 * ks); } \
        _Pragma("unroll") for (int vi = 0; vi < 4; ++vi) { const int co_ = h_ * 128 + 16 * (4 * vh + vi) + 4 * g; HF[vi] = *(const v2u*)(HGO + (size_t)TOK * 512 + co_); HB[vi] = *(const v2u*)(HGO + ((size_t)MT + TOK) * 512 + co_); \
            GR[vi] = *(const v2u*)(U + (size_t)TOK * IN_DIM + OFF_HG + co_); NN[vi] = *(const f32x4*)(ng + co_); } } while (0)
    bf16x8 qa[2][4], qb[2][4]; v2u hfa[4], hba[4], gra[4], hfb[4], hbb[4], grb[4]; f32x4 nna[4], nnb[4]; int toka = 0, tokb = 0;
    int ch = blockIdx.x, cur = 0;
    if (ch < nch) { RO_REGS(ch, qa, hfa, hba, gra, nna, toka); RO_DMA(ch, 0); }
    for (; ch < nch; ch += C.G) {
        const int nx = ch + C.G;
        if (nx < nch) { RO_REGS(nx, qb, hfb, hbb, grb, nnb, tokb); RO_DMA(nx, cur ^ 1); asm volatile("s_waitcnt vmcnt(32)" ::: "memory"); }
        else asm volatile("s_waitcnt vmcnt(0)" ::: "memory");
        __syncthreads();
        f32x4 acc[4];
#pragma unroll
        for (int vi = 0; vi < 4; ++vi) acc[vi] = (f32x4){bflo(hfa[vi].x) + bflo(hba[vi].x), bfhi(hfa[vi].x) + bfhi(hba[vi].x), bflo(hfa[vi].y) + bflo(hba[vi].y), bfhi(hfa[vi].y) + bfhi(hba[vi].y)};
        const LAS unsigned char* st = ring + cur * 65536 + (64 * vh + j16) * 256;
#pragma unroll
        for (int dir = 0; dir < 2; ++dir)
#pragma unroll
            for (int vi = 0; vi < 4; ++vi)
#pragma unroll
                for (int ks = 0; ks < 4; ++ks)
                    acc[vi] = __builtin_amdgcn_mfma_f32_16x16x32_bf16(*(const LAS bf16x8*)(st + dir * 32768 + vi * 4096 + (((4 * ks + g) ^ j16) << 4)), qa[dir][ks], acc[vi], 0, 0, 0);
        float ss = 0.f;
#pragma unroll
        for (int vi = 0; vi < 4; ++vi) ss += (acc[vi][0] * acc[vi][0] + acc[vi][1] * acc[vi][1]) + (acc[vi][2] * acc[vi][2] + acc[vi][3] * acc[vi][3]);
        ss += __shfl_xor(ss, 16); ss += __shfl_xor(ss, 32);
        if (g == 0) red[C.wave * 16 + j16] = ss;
        __syncthreads();
        const float s0 = red[tq * 16 + j16], s1 = red[(4 + tq) * 16 + j16];
        const float rs = rsqrtf((s0 + s1) * (1.f / 128.f) + EPS);
        { RO_DEC(ch, bh_, mc_); const int h_ = bh_ & 3; (void)mc_;
            unsigned char* op = CAT + (size_t)toka * D + 1536 + h_ * 128 + 16 * (4 * vh) + 4 * g;
#pragma unroll
            for (int vi = 0; vi < 4; ++vi) {
                const float r0 = acc[vi][0] * rs * nna[vi].x * silu(bflo(gra[vi].x)), r1 = acc[vi][1] * rs * nna[vi].y * silu(bfhi(gra[vi].x)), r2 = acc[vi][2] * rs * nna[vi].z * silu(bflo(gra[vi].y)), r3 = acc[vi][3] * rs * nna[vi].w * silu(bfhi(gra[vi].y));
                *(unsigned*)(op + 16 * vi) = pg8::cvt4_fp8(r0, r1, r2, r3); } }
#pragma unroll
        for (int dir = 0; dir < 2; ++dir)
#pragma unroll
            for (int ks = 0; ks < 4; ++ks) qa[dir][ks] = qb[dir][ks];
#pragma unroll
        for (int vi = 0; vi < 4; ++vi) { hfa[vi] = hfb[vi]; hba[vi] = hbb[vi]; gra[vi] = grb[vi]; nna[vi] = nnb[vi]; }
        toka = tokb; cur ^= 1;
    }
#undef RO_DEC
#undef RO_DMA
#undef RO_REGS
}
constexpr int CONVW_LDS = 57344;
__device__ __forceinline__ void conv_stage_w(const Args& a, const Ctx& C, int l) {
    const float* cw = AIN(I_CONVW) + (size_t)l * 31 * 512; LAS float* wl = (LAS float*)(C.lds + RING_OFF + CONVW_LDS);
    for (int i = C.tid * 4; i < 31 * 512; i += NTHREADS * 4) *(LAS f32x4*)(wl + i) = *(const f32x4*)(cw + i);
}
template <int R> __device__ __forceinline__ void conv_block(const Ctx& C, const bf16* U, unsigned char* CAT, const LAS float* wl, const float* cb, const float* lg, const float* lbb, int row0, int t0, int len) {
    constexpr int NI = R + 30;
    int ln_ = C.lane; asm volatile("" : "+v"(ln_));
    const int ch0 = ln_ * 8, seqbase = row0 - t0;
    v4u h[NI];
#pragma unroll
    for (int i = 0; i < NI; ++i) { const int tt = t0 - 15 + i; const unsigned long long in_ = (unsigned long long)(0ll - (long long)((unsigned)tt < (unsigned)len));
        const unsigned char* rp = C.ws + ((WS_U + (unsigned long long)(unsigned)(seqbase + tt) * (IN_DIM * 2)) & in_); h[i] = *(const v4u*)(rp + ch0 * 2); }
    __builtin_amdgcn_sched_barrier(0);
    float acc[R][8];
    { const f32x4 b0 = *(const f32x4*)(cb + ch0), b1 = *(const f32x4*)(cb + ch0 + 4);
#pragma unroll
        for (int r = 0; r < R; ++r) { acc[r][0] = b0.x; acc[r][1] = b0.y; acc[r][2] = b0.z; acc[r][3] = b0.w; acc[r][4] = b1.x; acc[r][5] = b1.y; acc[r][6] = b1.z; acc[r][7] = b1.w; } }
#pragma unroll
    for (int j = 0; j < 31; ++j) {
        const f32x4 w0 = *(const LAS f32x4*)(wl + j * 512 + ch0), w1 = *(const LAS f32x4*)(wl + j * 512 + ch0 + 4);
#pragma unroll
        for (int r = 0; r < R; ++r) { const v4u hv = h[r + j];
            acc[r][0] += w0.x * bflo(hv.x); acc[r][1] += w0.y * bfhi(hv.x); acc[r][2] += w0.z * bflo(hv.y); acc[r][3] += w0.w * bfhi(hv.y);
            acc[r][4] += w1.x * bflo(hv.z); acc[r][5] += w1.y * bfhi(hv.z); acc[r][6] += w1.z * bflo(hv.w); acc[r][7] += w1.w * bfhi(hv.w); }
        if ((j & 3) == 3) {
#pragma unroll
            for (int r = 0; r < R; ++r) asm volatile("" : "+v"(acc[r][0]), "+v"(acc[r][1]), "+v"(acc[r][2]), "+v"(acc[r][3]), "+v"(acc[r][4]), "+v"(acc[r][5]), "+v"(acc[r][6]), "+v"(acc[r][7]) :: "memory");
            __builtin_amdgcn_sched_barrier(0); }
    }
    const f32x4 g0 = *(const f32x4*)(lg + ch0), g1 = *(const f32x4*)(lg + ch0 + 4), c0 = *(const f32x4*)(lbb + ch0), c1 = *(const f32x4*)(lbb + ch0 + 4);
    const float gg[8] = {g0.x, g0.y, g0.z, g0.w, g1.x, g1.y, g1.z, g1.w}, bb[8] = {c0.x, c0.y, c0.z, c0.w, c1.x, c1.y, c1.z, c1.w};
#pragma unroll
    for (int r = 0; r < R; ++r) {
        float sm = 0.f;
#pragma unroll
        for (int i = 0; i < 8; ++i) sm += acc[r][i];
        const float mean = wave_sum(sm) * (1.f / 512.f); float qq = 0.f;
#pragma unroll
        for (int i = 0; i < 8; ++i) { acc[r][i] -= mean; qq += acc[r][i] * acc[r][i]; }
        const float rs = rsqrtf(wave_sum(qq) * (1.f / 512.f) + EPS);
        float o[8];
#pragma unroll
        for (int i = 0; i < 8; ++i) o[i] = silu(acc[r][i] * rs * gg[i] + bb[i]);
        v2u w; w.x = pg8::cvt4_fp8(o[0], o[1], o[2], o[3]); w.y = pg8::cvt4_fp8(o[4], o[5], o[6], o[7]);
        *(v2u*)(CAT + (size_t)(row0 + r) * D + ch0) = w;
    }
}
__device__ __forceinline__ void ph_conv(const Args& a, const Ctx& C, int l, int nrows) {
    const bf16* U = (const bf16*)(C.ws + WS_U); unsigned char* CAT = (unsigned char*)(C.ws + WS_CAT);
    const float* cb = AIN(I_CONVB) + (size_t)l * 512; const float* lg = AIN(I_CLNG) + (size_t)l * 512; const float* lbb = AIN(I_CLNB) + (size_t)l * 512;
    const LAS float* wl = (const LAS float*)(C.lds + RING_OFF + CONVW_LDS);
    for (int blk = C.gw; blk < ML / 4; blk += C.NGW) { const int row0 = 4 * blk; conv_block<4>(C, U, CAT, wl, cb, lg, lbb, row0, row0 & (SEQ_T - 1), SEQ_T); }
    for (int row = ML + C.wave * C.G + (int)blockIdx.x; row < nrows; row += C.NGW) conv_block<1>(C, U, CAT, wl, cb, lg, lbb, row, (row - ML) & (CTX_L - 1), CTX_L);
}
template <bool WIN> __device__ __forceinline__ void ph_attn(const Args& a, const Ctx& C, int l, int gw, int ngw) {
    const bf16* U = (const bf16*)(C.ws + WS_U); const bf16* VT = (const bf16*)(C.ws + WS_VT); bf16* CAT = (bf16*)(C.ws + WS_CAT);
    constexpr int NG = WIN ? 16 : 8, GW = WIN ? 8 : 0, NB2 = NG / 2;
    const int nunits = WIN ? NB * 16 * 64 * 4 : NB * 16 * 16;
    const int q = C.lane & 15, g = C.lane >> 4;
    LAS float* rl = (LAS float*)(C.lds + RING_OFF) + C.wave * 512;
    const int xcd = blockIdx.x & 7, nlu = nunits / 8;
    for (int lu = gw; lu < nlu; lu += ngw) {
        int b, h, r = 0, j, tokq;
        if (WIN) { const int pair = xcd * 8 + (lu >> 8); j = lu & 3; r = (lu >> 2) & 63; h = pair & 15; b = pair >> 4; tokq = b * SEQ_T + r * 64 + 16 * j + q; }
        else { const int pair = xcd * 8 + (lu >> 4); j = lu & 15; h = pair & 15; b = pair >> 4; tokq = ML + b * CTX_L + 16 * j + q; }
        const int sr = min(max(r - 4, 0), 56), kstart = min(max(16 * j - 8, 0), 32);
        const int c = 16 * j + q, wsq = min(max(c - 8, 0), 48);
        if (WIN) { const float* rpb = AIN(I_RPB) + (size_t)(l * 16 + h) * 465; float tv[8];
#pragma unroll
            for (int i = 0; i < 8; ++i) tv[i] = rpb[min(C.lane + 64 * i, 464)];
            LDS_WAIT(); asm volatile("" ::: "memory");
#pragma unroll
            for (int i = 0; i < 8; ++i) if (C.lane + 64 * i < 465) rl[C.lane + 64 * i] = tv[i]; }
        const bf16* qp = U + (size_t)tokq * IN_DIM + OFF_Q + h * 64 + 8 * g;
        const bf16x8 qf0 = *(const bf16x8*)qp, qf1 = *(const bf16x8*)(qp + 32);
        const bf16* kbase = U + (size_t)(8 * (q >> 2) + (q & 3)) * IN_DIM + OFF_K + h * 64 + 8 * g;
#define NA_TOK0(G) ((WIN && (G) < GW) ? b * SEQ_T + (sr + (G)) * 64 + kstart : ML + b * CTX_L + 32 * ((G) - GW))
        constexpr int PD = 4;
        f32x4 s[NG][2]; bf16x8 kr[PD][4];
#pragma unroll
        for (int u = 0; u < PD; ++u) { const bf16* kp = kbase + (size_t)NA_TOK0(u) * IN_DIM;
            kr[u][0] = *(const bf16x8*)kp; kr[u][1] = *(const bf16x8*)(kp + 32); kr[u][2] = *(const bf16x8*)(kp + 4 * IN_DIM); kr[u][3] = *(const bf16x8*)(kp + 4 * IN_DIM + 32); }
        LDS_WAIT(); asm volatile("" ::: "memory");
        __builtin_amdgcn_sched_barrier(0);
#pragma unroll
        for (int G = 0; G < NG; ++G) { const int u = G % PD; const f32x4 z = {0.f, 0.f, 0.f, 0.f};
            f32x4 s0 = __builtin_amdgcn_mfma_f32_16x16x32_bf16(kr[u][0], qf0, z, 0, 0, 0); s0 = __builtin_amdgcn_mfma_f32_16x16x32_bf16(kr[u][1], qf1, s0, 0, 0, 0);
            f32x4 s1 = __builtin_amdgcn_mfma_f32_16x16x32_bf16(kr[u][2], qf0, z, 0, 0, 0); s1 = __builtin_amdgcn_mfma_f32_16x16x32_bf16(kr[u][3], qf1, s1, 0, 0, 0);
            if (G + PD < NG) { const bf16* kp = kbase + (size_t)NA_TOK0(G + PD) * IN_DIM;
                kr[u][0] = *(const bf16x8*)kp; kr[u][1] = *(const bf16x8*)(kp + 32); kr[u][2] = *(const bf16x8*)(kp + 4 * IN_DIM); kr[u][3] = *(const bf16x8*)(kp + 4 * IN_DIM + 32); }
            if (WIN && G < GW) { const LAS float* rrow = rl + (sr + G - r + 7) * 31;
#pragma unroll
                for (int t = 0; t < 4; ++t) { const int kc0 = kstart + 8 * g + t, kc1 = kc0 + 4;
                    const bool ok0 = kc0 >= wsq && kc0 < wsq + 16, ok1 = kc1 >= wsq && kc1 < wsq + 16;
                    const float b0 = rrow[min(max(kc0 - c + 15, 0), 30)], b1 = rrow[min(max(kc1 - c + 15, 0), 30)];
                    s0[t] = ok0 ? s0[t] * 0.125f + b0 : -1e30f; s1[t] = ok1 ? s1[t] * 0.125f + b1 : -1e30f; } }
            else { s0 = s0 * 0.125f; s1 = s1 * 0.125f; }
            s[G][0] = s0; s[G][1] = s1;
            __builtin_amdgcn_sched_barrier(0);
        }
        float m = -3.0e38f;
#pragma unroll
        for (int G = 0; G < NG; ++G)
#pragma unroll
            for (int t = 0; t < 4; ++t) m = fmaxf(m, fmaxf(s[G][0][t], s[G][1][t]));
        m = fmaxf(m, __shfl_xor(m, 16)); m = fmaxf(m, __shfl_xor(m, 32));
        const bf16* vbase = VT + (size_t)(h * 64 + q) * MT + 8 * g;
        bf16x8 vr[PD][4];
#pragma unroll
        for (int u = 0; u < PD; ++u)
#pragma unroll
            for (int dt = 0; dt < 4; ++dt) vr[u][dt] = *(const bf16x8*)(vbase + (size_t)(16 * dt) * MT + NA_TOK0(u));
        __builtin_amdgcn_sched_barrier(0);
        float ps = 0.f; bf16x8 pf[NG];
#pragma unroll
        for (int G = 0; G < NG; ++G) { float p[8];
#pragma unroll
            for (int t = 0; t < 4; ++t) { p[t] = __expf(s[G][0][t] - m); p[4 + t] = __expf(s[G][1][t] - m); ps += p[t] + p[4 + t]; }
            v4u w; w.x = pg8::cvt_pk_bf16(p[0], p[1]); w.y = pg8::cvt_pk_bf16(p[2], p[3]); w.z = pg8::cvt_pk_bf16(p[4], p[5]); w.w = pg8::cvt_pk_bf16(p[6], p[7]);
            pf[G] = __builtin_bit_cast(bf16x8, w); }
        ps += __shfl_xor(ps, 16); ps += __shfl_xor(ps, 32);
        const float inv = __builtin_amdgcn_rcpf(ps);
        f32x4 o[4];
#pragma unroll
        for (int dt = 0; dt < 4; ++dt) o[dt] = (f32x4){0.f, 0.f, 0.f, 0.f};
        __builtin_amdgcn_sched_barrier(0);
#pragma unroll
        for (int G = 0; G < NG; ++G) { const int u = G % PD;
#pragma unroll
            for (int dt = 0; dt < 4; ++dt) o[dt] = __builtin_amdgcn_mfma_f32_16x16x32_bf16(vr[u][dt], pf[G], o[dt], 0, 0, 0);
            if (G + PD < NG) {
#pragma unroll
                for (int dt = 0; dt < 4; ++dt) vr[u][dt] = *(const bf16x8*)(vbase + (size_t)(16 * dt) * MT + NA_TOK0(G + PD)); }
            __builtin_amdgcn_sched_barrier(0);
        }
#undef NA_TOK0
        bf16* op = CAT + (size_t)tokq * D + 512 + h * 64 + 4 * g;
#pragma unroll
        for (int dt = 0; dt < 4; ++dt) { v2u w; w.x = pg8::cvt_pk_bf16(o[dt][0] * inv, o[dt][1] * inv); w.y = pg8::cvt_pk_bf16(o[dt][2] * inv, o[dt][3] * inv); *(v2u*)(op + 16 * dt) = w; }
    }
}

template <bool WIN> __device__ __forceinline__ void ph_attn_lds(const Args& a, const Ctx& C, int l) {
    const bf16* U = (const bf16*)(C.ws + WS_U); const bf16* VT = (const bf16*)(C.ws + WS_VT); bf16* CAT = (bf16*)(C.ws + WS_CAT);
    constexpr int NG = WIN ? 16 : 8, GW = WIN ? 8 : 0;
    constexpr int KSTR = 144, VWSTR = 1168, VCSTR = 528;
    constexpr int KC_OFF = WIN ? 576 * KSTR : 0, VC_OFF = WIN ? 64 * VWSTR : 0, RL_OFF = 119808;
    LAS unsigned char* L0 = C.lds + RING_OFF; LAS float* rl = (LAS float*)(L0 + RL_OFF);
    const int w = C.wave;
    const int xcd = blockIdx.x & 7, bix = blockIdx.x >> 3, nbx = C.G >> 3;
    constexpr int NUN = WIN ? 8 * 32 : 8 * 2;
    v4u kw[9], kc[4]; float bt = 0.f; bf16x8 qf0, qf1;
#define NA_KLOAD(lu_) do { int ty_ = C.tid; asm volatile("" : "+v"(ty_)); const int pr_ = xcd * 8 + (WIN ? ((lu_) >> 5) : ((lu_) >> 1)), b_ = pr_ >> 4, h_ = pr_ & 15, rp_ = (lu_) & 31; \
        const int s0_ = min(max(2 * rp_ - 4, 0), 56), nw_ = min(9, 64 - s0_), g0_ = b_ * SEQ_T + s0_ * 64, c0_ = ML + b_ * CTX_L; \
        const int r_ = WIN ? 2 * rp_ + (w >> 2) : 0, j_ = WIN ? (w & 3) : (((lu_) & 1) * 8 + w), tq_ = WIN ? b_ * SEQ_T + r_ * 64 + 16 * j_ + (ty_ & 15) : c0_ + 16 * j_ + (ty_ & 15); \
        const bf16* qp_ = U + (size_t)tq_ * IN_DIM + OFF_Q + h_ * 64 + 8 * ((ty_ >> 4) & 3); qf0 = *(const bf16x8*)qp_; qf1 = *(const bf16x8*)(qp_ + 32); \
        if (WIN) { _Pragma("unroll") for (int i = 0; i < 9; ++i) { const int cc = ty_ + 512 * i, tl = min(cc >> 3, nw_ * 64 - 1); kw[i] = *(const v4u*)(U + (size_t)(g0_ + tl) * IN_DIM + OFF_K + h_ * 64 + (cc & 7) * 8); } \
            bt = AIN(I_RPB)[(size_t)(l * 16 + h_) * 465 + min(ty_, 464)]; } \
        _Pragma("unroll") for (int i = 0; i < 4; ++i) { const int cc = ty_ + 512 * i; kc[i] = *(const v4u*)(U + (size_t)(c0_ + (cc >> 3)) * IN_DIM + OFF_K + h_ * 64 + (cc & 7) * 8); } } while (0)
    if (bix < NUN) NA_KLOAD(bix);
    for (int lu = bix; lu < NUN; lu += nbx) {
        int tz_ = C.tid; asm volatile("" : "+v"(tz_));
        const int tid = tz_, q = tid & 15, g = (tid >> 4) & 3;
        const int pair = xcd * 8 + (WIN ? (lu >> 5) : (lu >> 1)), b = pair >> 4, h = pair & 15;
        const int rp = lu & 31, r = WIN ? 2 * rp + (w >> 2) : 0, j = WIN ? (w & 3) : ((lu & 1) * 8 + w);
        const int sr0 = min(max(2 * rp - 4, 0), 56), nwr = min(9, 64 - sr0), gtok0 = b * SEQ_T + sr0 * 64, ctok0 = ML + b * CTX_L;
        const int sr = min(max(r - 4, 0), 56), kstart = min(max(16 * j - 8, 0), 32);
        const int c = 16 * j + q, wsq = min(max(c - 8, 0), 48);
        const int tokq = WIN ? b * SEQ_T + r * 64 + c : ctok0 + c;
        v4u vw[9], vc[4];
#define NA_VLOAD() do { if (WIN) { _Pragma("unroll") for (int i = 0; i < 9; ++i) { const int cc = tid + 512 * i, d = cc / 72, ch = cc % 72; vw[i] = *(const v4u*)(VT + (size_t)(h * 64 + d) * MT + gtok0 + min(ch, nwr * 8 - 1) * 8); } } } while (0)
#define NA_VLOADC() do { _Pragma("unroll") for (int i = 0; i < 4; ++i) { const int cc = tid + 512 * i; vc[i] = *(const v4u*)(VT + (size_t)(h * 64 + (cc >> 5)) * MT + ctok0 + (cc & 31) * 8); } } while (0)
        { if (WIN) {
#pragma unroll
                for (int i = 0; i < 9; ++i) { const int cc = tid + 512 * i; if ((cc >> 3) < nwr * 64) *(LAS v4u*)(L0 + (cc >> 3) * KSTR + (cc & 7) * 16) = kw[i]; }
                if (tid < 465) rl[tid] = bt; }
#pragma unroll
            for (int i = 0; i < 4; ++i) { const int cc = tid + 512 * i; *(LAS v4u*)(L0 + KC_OFF + (cc >> 3) * KSTR + (cc & 7) * 16) = kc[i]; }
        }
        __syncthreads();
        NA_VLOAD();
        __builtin_amdgcn_sched_barrier(0);
#define NL_TOKL(G) ((WIN && (G) < GW) ? (sr + (G) - sr0) * 64 + kstart : 32 * ((G) - GW))
        const int bidx = kstart + 8 * g - c + 15; int mbits = 0;
#pragma unroll
        for (int t = 0; t < 8; ++t) { const int kc = kstart + 8 * g + t; mbits |= (kc >= wsq && kc < wsq + 16) ? (1 << t) : 0; }
        constexpr int NH = WIN ? 2 : 1;
        bf16x8 pf[NG]; float mh[NH], lh[NH];
#pragma unroll
        for (int hh = 0; hh < NH; ++hh) {
            f32x4 s[8][2];
#pragma unroll
            for (int gg = 0; gg < 8; ++gg) { const int G = 8 * hh + gg;
                const LAS unsigned char* kp = L0 + ((WIN && G < GW) ? 0 : KC_OFF) + (NL_TOKL(G) + 8 * (q >> 2) + (q & 3)) * KSTR + 16 * g;
                const bf16x8 k00 = *(const LAS bf16x8*)kp, k01 = *(const LAS bf16x8*)(kp + 64), k10 = *(const LAS bf16x8*)(kp + 4 * KSTR), k11 = *(const LAS bf16x8*)(kp + 4 * KSTR + 64);
                const f32x4 z = {0.f, 0.f, 0.f, 0.f};
                f32x4 s0 = __builtin_amdgcn_mfma_f32_16x16x32_bf16(k00, qf0, z, 0, 0, 0); s0 = __builtin_amdgcn_mfma_f32_16x16x32_bf16(k01, qf1, s0, 0, 0, 0);
                f32x4 s1 = __builtin_amdgcn_mfma_f32_16x16x32_bf16(k10, qf0, z, 0, 0, 0); s1 = __builtin_amdgcn_mfma_f32_16x16x32_bf16(k11, qf1, s1, 0, 0, 0);
                if (WIN && G < GW) { const LAS float* rrow = rl + (sr + G - r + 7) * 31 + bidx;
#pragma unroll
                    for (int t = 0; t < 4; ++t) { const int k0 = __builtin_amdgcn_sbfe(mbits, t, 1), k1 = __builtin_amdgcn_sbfe(mbits, 4 + t, 1);
                        const float b0 = __builtin_bit_cast(float, (__builtin_bit_cast(int, rrow[t]) & k0) | (0xf149f2ca & ~k0)), b1 = __builtin_bit_cast(float, (__builtin_bit_cast(int, rrow[4 + t]) & k1) | (0xf149f2ca & ~k1));
                        s0[t] = s0[t] * 0.125f + b0; s1[t] = s1[t] * 0.125f + b1; } }
                else { s0 = s0 * 0.125f; s1 = s1 * 0.125f; }
                s[gg][0] = s0; s[gg][1] = s1;
                if (gg & 1) __builtin_amdgcn_sched_barrier(0);
            }
            float m = -3.0e38f;
#pragma unroll
            for (int gg = 0; gg < 8; ++gg)
#pragma unroll
                for (int t = 0; t < 4; ++t) m = fmaxf(m, fmaxf(s[gg][0][t], s[gg][1][t]));
            m = fmaxf(m, __shfl_xor(m, 16)); m = fmaxf(m, __shfl_xor(m, 32));
            const float m2 = m * 1.44269504f;
            float ps = 0.f;
#pragma unroll
            for (int gg = 0; gg < 8; ++gg) { float p[8];
#pragma unroll
                for (int t = 0; t < 4; ++t) { p[t] = __builtin_amdgcn_exp2f(__builtin_fmaf(s[gg][0][t], 1.44269504f, -m2)); p[4 + t] = __builtin_amdgcn_exp2f(__builtin_fmaf(s[gg][1][t], 1.44269504f, -m2)); ps += p[t] + p[4 + t]; }
                v4u pw; pw.x = pk2(p[0], p[1]); pw.y = pk2(p[2], p[3]); pw.z = pk2(p[4], p[5]); pw.w = pk2(p[6], p[7]);
                pf[8 * hh + gg] = __builtin_bit_cast(bf16x8, pw); }
            ps += __shfl_xor(ps, 16); ps += __shfl_xor(ps, 32);
            mh[hh] = m; lh[hh] = ps;
            __builtin_amdgcn_sched_barrier(0);
        }
        float ah[NH]; float inv;
        { const float mm = NH == 2 ? fmaxf(mh[0], mh[NH - 1]) : mh[0]; float L = 0.f;
#pragma unroll
            for (int hh = 0; hh < NH; ++hh) { ah[hh] = __expf(mh[hh] - mm); L += lh[hh] * ah[hh]; }
            inv = __builtin_amdgcn_rcpf(L); }
        NA_VLOADC();
        __builtin_amdgcn_sched_barrier(0);
        __syncthreads();
        if (WIN) {
#pragma unroll
            for (int i = 0; i < 9; ++i) { const int cc = tid + 512 * i, d = cc / 72, ch = cc % 72; if (ch < nwr * 8) *(LAS v4u*)(L0 + d * VWSTR + ch * 16) = vw[i]; } }
#pragma unroll
        for (int i = 0; i < 4; ++i) { const int cc = tid + 512 * i; *(LAS v4u*)(L0 + VC_OFF + (cc >> 5) * VCSTR + (cc & 31) * 16) = vc[i]; }
        __syncthreads();
        { const int lun = min(lu + nbx, NUN - 1); NA_KLOAD(lun); }
        __builtin_amdgcn_sched_barrier(0);
        f32x4 oh[NH][4];
#pragma unroll
        for (int hh = 0; hh < NH; ++hh)
#pragma unroll
            for (int dt = 0; dt < 4; ++dt) oh[hh][dt] = (f32x4){0.f, 0.f, 0.f, 0.f};
#pragma unroll
        for (int G = 0; G < NG; ++G) {
            const LAS unsigned char* vp = (WIN && G < GW) ? L0 + q * VWSTR + (NL_TOKL(G) + 8 * g) * 2 : L0 + VC_OFF + q * VCSTR + (NL_TOKL(G) + 8 * g) * 2;
            const int dstr = (WIN && G < GW) ? 16 * VWSTR : 16 * VCSTR;
#pragma unroll
            for (int dt = 0; dt < 4; ++dt) oh[G / 8][dt] = __builtin_amdgcn_mfma_f32_16x16x32_bf16(*(const LAS bf16x8*)(vp + dt * dstr), pf[G], oh[G / 8][dt], 0, 0, 0);
            if (G & 1) __builtin_amdgcn_sched_barrier(0);
        }
        f32x4 o[4];
#pragma unroll
        for (int dt = 0; dt < 4; ++dt) { o[dt] = oh[0][dt] * ah[0]; if (NH == 2) o[dt] = o[dt] + oh[NH - 1][dt] * ah[NH - 1]; }
#undef NL_TOKL
#undef NA_VLOAD
#undef NA_VLOADC
#undef NA_KLOAD
        unsigned char* op = (unsigned char*)CAT + (size_t)tokq * D + 512 + h * 64 + 4 * g; const float invs = inv * CAT_NA_SC;
#pragma unroll
        for (int dt = 0; dt < 4; ++dt) *(unsigned*)(op + 16 * dt) = pg8::cvt4_fp8(o[dt][0] * invs, o[dt][1] * invs, o[dt][2] * invs, o[dt][3] * invs);
        __syncthreads();
    }
}

constexpr int RW_ELEMS = 5 * 48 * 2048;
__device__ __forceinline__ void ph_router_prep(const Args& a, const Ctx& C, int l) {
    float* RW = (float*)(C.ws + WS_RW); float* RC = RW + RW_ELEMS; float* RG = RC + 256;
    const float* gffn = AIN(I_GFFN) + (size_t)l * D; const float* wrg = AIN(I_WRG) + (size_t)l * D * 4; const float* wre = AIN(I_WRE) + (size_t)l * D * 32;
    for (int idx = blockIdx.x * NTHREADS + C.tid; idx < RW_ELEMS; idx += C.G * NTHREADS) {
        const int r = idx / (48 * 2048), rem = idx % (48 * 2048), o = rem >> 11, k = rem & 2047;
        const float gs = gffn[k] * (1.f + modp(C, l, r, 4)[k]);
        const float w = o < 4 ? wrg[k * 4 + o] : (o < 36 ? wre[k * 32 + (o - 4)] : 0.f);
        RW[idx] = gs * w; if (o == 0) RG[r * 2048 + k] = gs; }
    for (int u = C.gw; u < 5 * 36; u += C.NGW) { const int r = u / 36, o = u % 36; const float* sh2 = modp(C, l, r, 3); float p = 0.f;
        for (int k = C.lane; k < 2048; k += 64) p += sh2[k] * (o < 4 ? wrg[k * 4 + o] : wre[k * 32 + (o - 4)]);
        p = wave_sum(p); if (C.lane == 0) RC[r * 48 + o] = p + (o < 4 ? AIN(I_BRG)[l * 4 + o] : AIN(I_BRE)[l * 32 + (o - 4)]); }
}
template <int NP> __device__ __forceinline__ void router_blocks(const Args& a, const Ctx& C, int l, int blk0, int nblk, bool commit) {
    const float* XL = (const float*)(C.ws + WS_XL);
    int* tokE = (int*)(C.ws + WS_TAB + TB_TOKE); float* tokW = (float*)(C.ws + WS_TAB + TB_TOKW); int* tokP = (int*)(C.ws + WS_TAB + TB_TOKP);
    unsigned* cnt = (unsigned*)(C.ws + WS_CTL) + CW_CNT + l * 64;
    const float* RW = (const float*)(C.ws + WS_RW); const float* RC = RW + RW_ELEMS; float* RS = (float*)(C.ws + WS_TAB + TB_RS);
    constexpr int GPW = 8 / NP, NBATCH = 32 / NP;
    const int pr = C.wave / NP, half = C.wave % NP;
    LAS float* part = (LAS float*)(C.lds + RING_OFF) + (pr * (NP - 1) + (half > 0 ? half - 1 : 0)) * 1024;
    LAS float* lg = (LAS float*)(C.lds + RING_OFF) + 8192 + pr * 1024;
    const int i16 = C.lane & 15, kk = C.lane >> 4;
    const int nit = (nblk + GPW - 1) / GPW;
    for (int it = blockIdx.x; it < nit; it += C.G) {
        const int blk = it * GPW + pr; const bool act = blk < nblk;
        const int row0 = (blk0 + (act ? blk : 0)) * 16, r = row0 < ML ? (row0 >> 12) : 4;
        f32x4 acc[3]; float ss = 0.f;
#pragma unroll
        for (int nt = 0; nt < 3; ++nt) acc[nt] = (f32x4){0.f, 0.f, 0.f, 0.f};
        if constexpr (NP == 2) {
            const int rwg = ((blk0 + it * GPW) * 16) >> 12;
            const float* xp = XL + (size_t)(row0 + i16) * D + 4 * kk + 1024 * half; const float* wsrc = RW + (size_t)rwg * 48 * 2048 + 1024 * half;
            LAS unsigned char* wslot = C.lds + RING_OFF + 49152 + half * 12288;
            f32x4 xr[4][4];
#define RT_LOADX(slot, batch) do { _Pragma("unroll") for (int u = 0; u < 4; ++u) xr[slot][u] = *(const f32x4*)(xp + 16 * (4 * (batch) + u)); } while (0)
#define RT_DMA(batch) do { _Pragma("unroll") for (int i = 0; i < 3; ++i) { const int I_ = pr * 3 + i, row_ = 4 * I_ + kk, ck_ = i16 ^ (row_ & 15); \
                __builtin_amdgcn_global_load_lds((const unsigned*)(wsrc + (size_t)row_ * 2048 + 64 * (batch) + 4 * ck_), (LAS unsigned*)(wslot + ((batch) % 3) * 24576 + I_ * 1024), 16, 0, 0); } } while (0)
            RT_LOADX(0, 0); RT_LOADX(1, 1); RT_LOADX(2, 2); RT_LOADX(3, 3); RT_DMA(0); RT_DMA(1);
            __builtin_amdgcn_sched_barrier(0);
#pragma unroll
            for (int bi = 0; bi < NBATCH; ++bi) {
                const int nw = bi == 0 ? 3 : bi == 1 ? 7 : bi <= 12 ? 11 : bi == 13 ? 7 : bi == 14 ? 3 : 0;
                if (nw == 11) asm volatile("s_waitcnt vmcnt(11)" ::: "memory"); else if (nw == 7) asm volatile("s_waitcnt vmcnt(7)" ::: "memory"); else if (nw == 3) asm volatile("s_waitcnt vmcnt(3)" ::: "memory"); else asm volatile("s_waitcnt vmcnt(0)" ::: "memory");
                __syncthreads();
                if (bi + 2 < NBATCH) RT_DMA(bi + 2);
                __builtin_amdgcn_sched_barrier(0);
                const LAS unsigned char* wl_ = wslot + (bi % 3) * 24576 + i16 * 256;
#pragma unroll
                for (int u = 0; u < 4; ++u) { const f32x4 xv = xr[bi & 3][u]; f32x4 wv[3];
#pragma unroll
                    for (int nt = 0; nt < 3; ++nt) wv[nt] = *(const LAS f32x4*)(wl_ + nt * 4096 + (((4 * u + kk) ^ i16) << 4));
                    ss += (xv.x * xv.x + xv.y * xv.y) + (xv.z * xv.z + xv.w * xv.w);
#pragma unroll
                    for (int m = 0; m < 4; ++m)
#pragma unroll
                        for (int nt = 0; nt < 3; ++nt) acc[nt] = __builtin_amdgcn_mfma_f32_16x16x4f32(xv[m], wv[nt][m], acc[nt], 0, 0, 0); }
                if (bi + 4 < NBATCH) RT_LOADX(bi & 3, bi + 4);
                __builtin_amdgcn_sched_barrier(0);
            }
#undef RT_LOADX
#undef RT_DMA
            if (act && half) {
#pragma unroll
                for (int nt = 0; nt < 3; ++nt)
#pragma unroll
                    for (int t = 0; t < 4; ++t) part[(nt * 4 + t) * 64 + C.lane] = acc[nt][t];
                part[12 * 64 + C.lane] = ss; }
        } else
        if (act) {
            const float* xp = XL + (size_t)(row0 + i16) * D + 4 * kk + (2048 / NP) * half; const float* wp = RW + ((size_t)r * 48 + i16) * 2048 + 4 * kk + (2048 / NP) * half;
            f32x4 xr[4][4], wq[2][4][3];
#define RT_LOADX(slot, batch) do { _Pragma("unroll") for (int u = 0; u < 4; ++u) xr[slot][u] = *(const f32x4*)(xp + 16 * (4 * (batch) + u)); } while (0)
#define RT_LOADW(slot, batch) do { _Pragma("unroll") for (int u = 0; u < 4; ++u) _Pragma("unroll") for (int nt = 0; nt < 3; ++nt) wq[slot][u][nt] = *(const f32x4*)(wp + (size_t)nt * 16 * 2048 + 16 * (4 * (batch) + u)); } while (0)
            RT_LOADX(0, 0); RT_LOADX(1, 1); RT_LOADX(2, 2); RT_LOADX(3, 3); RT_LOADW(0, 0);
            __builtin_amdgcn_sched_barrier(0);
#pragma unroll
            for (int bi = 0; bi < NBATCH; ++bi) {
                if (bi + 1 < NBATCH) RT_LOADW((bi + 1) & 1, bi + 1);
                __builtin_amdgcn_sched_barrier(0);
#pragma unroll
                for (int u = 0; u < 4; ++u) { const f32x4 xv = xr[bi & 3][u];
                    ss += (xv.x * xv.x + xv.y * xv.y) + (xv.z * xv.z + xv.w * xv.w);
#pragma unroll
                    for (int m = 0; m < 4; ++m)
#pragma unroll
                        for (int nt = 0; nt < 3; ++nt) acc[nt] = __builtin_amdgcn_mfma_f32_16x16x4f32(xv[m], wq[bi & 1][u][nt][m], acc[nt], 0, 0, 0); }
                if (bi + 4 < NBATCH) RT_LOADX(bi & 3, bi + 4);
                __builtin_amdgcn_sched_barrier(0);
            }
#undef RT_LOADX
#undef RT_LOADW
            if (half) {
#pragma unroll
                for (int nt = 0; nt < 3; ++nt)
#pragma unroll
                    for (int t = 0; t < 4; ++t) part[(nt * 4 + t) * 64 + C.lane] = acc[nt][t];
                part[12 * 64 + C.lane] = ss; }
        }
        __syncthreads();
        if (act && !half) {
#pragma unroll
            for (int pp = 0; pp < NP - 1; ++pp) { const LAS float* pq = part + pp * 1024;
#pragma unroll
                for (int nt = 0; nt < 3; ++nt)
#pragma unroll
                    for (int t = 0; t < 4; ++t) acc[nt][t] += pq[(nt * 4 + t) * 64 + C.lane];
                ss += pq[12 * 64 + C.lane]; }
            ss += __shfl_xor(ss, 16); ss += __shfl_xor(ss, 32);
            const float rs = rsqrtf(ss * (1.f / D) + EPS);
#pragma unroll
            for (int nt = 0; nt < 3; ++nt)
#pragma unroll
                for (int t = 0; t < 4; ++t) lg[(4 * kk + t) * 48 + 16 * nt + i16] = acc[nt][t];
            if (kk == 0) lg[768 + i16] = rs;
        }
        __syncthreads();
        if (act && !half && C.lane < 16 && commit) { const int row = row0 + C.lane; const float rst = lg[768 + C.lane]; const LAS float* lr = lg + C.lane * 48; const float* rc = RC + r * 48;
            float gl[4];
#pragma unroll
            for (int i = 0; i < 4; ++i) gl[i] = rst * lr[i] + rc[i];
            int grp = 0; float gm = gl[0];
#pragma unroll
            for (int i = 1; i < 4; ++i) if (gl[i] > gm) { gm = gl[i]; grp = i; }
            float gz = 0.f;
#pragma unroll
            for (int i = 0; i < 4; ++i) gz += __expf(gl[i] - gm);
            const float pgrp = 1.f / gz;
            int i1 = 0, i2 = -1; float m1 = -3.0e38f, m2 = -3.0e38f;
            for (int i = 0; i < 8; ++i) { const float v = rst * lr[4 + grp * 8 + i] + rc[4 + grp * 8 + i];
                if (v > m1) { m2 = m1; i2 = i1; m1 = v; i1 = i; } else if (v > m2) { m2 = v; i2 = i; } }
            const float e2 = __expf(m2 - m1), w1 = pgrp / (1.f + e2), w2 = pgrp * e2 / (1.f + e2);
            const int ea = grp * 8 + i1, eb = grp * 8 + i2;
            const unsigned pa = atomicAdd(cnt + ea, 1u), pb = atomicAdd(cnt + eb, 1u);
            tokE[2 * row] = ea; tokE[2 * row + 1] = eb; tokW[2 * row] = w1; tokW[2 * row + 1] = w2; tokP[2 * row] = (int)pa; tokP[2 * row + 1] = (int)pb; }
        if (act && !half && kk == 0 && commit) RS[row0 + i16] = lg[768 + i16];
    }
}
__device__ __forceinline__ void ph_norm2_router(const Args& a, const Ctx& C, int l, int nrows, bool commit) {
    router_blocks<2>(a, C, l, 0, ML / 16, commit);
    if (nrows > ML) { __syncthreads(); router_blocks<8>(a, C, l, ML / 16, (nrows - ML) / 16, commit); }
}
__device__ __forceinline__ void ph_moe_gather(const Args& a, const Ctx& C, int l, int nrows) {
    const float* XL = (const float*)(C.ws + WS_XL); unsigned char* XS = (unsigned char*)(C.ws + WS_XS);
    const int* tokE = (const int*)(C.ws + WS_TAB + TB_TOKE); const float* tokW = (const float*)(C.ws + WS_TAB + TB_TOKW); const int* tokP = (const int*)(C.ws + WS_TAB + TB_TOKP);
    int* sdst = (int*)(C.ws + WS_TAB + TB_SDST); float* sw = (float*)(C.ws + WS_TAB + TB_SW); int* tile_e = (int*)(C.ws + WS_TAB + TB_TILEE); int* ntl = (int*)(C.ws + WS_TAB + TB_NT);
    const float* RS = (const float*)(C.ws + WS_TAB + TB_RS); const float* RG = (const float*)(C.ws + WS_RW) + RW_ELEMS + 256;
    const unsigned* cnt = (const unsigned*)(C.ws + WS_CTL) + CW_CNT + l * 64;
    LAS int* sh = (LAS int*)(C.lds + RING_OFF);
    if (C.tid == 0) { int acc = 0; for (int e = 0; e < NE; ++e) { const int c = (int)cnt[e]; sh[e] = acc; sh[64 + e] = c; acc += (c + 255) / 256 * 256; } sh[32] = acc; }
    __syncthreads();
    const int ptot = sh[32];
    if (blockIdx.x == 0) {
        for (int i = C.tid; i < ptot / 256; i += NTHREADS) { int e = 0; while (e < NE - 1 && sh[e + 1] <= i * 256) ++e; tile_e[i] = e; }
        if (C.tid == 0) *ntl = ptot / 256;
    }
    for (int e = blockIdx.x; e < NE; e += C.G) for (int s = sh[e] + sh[64 + e] + C.tid; s < sh[e + 1]; s += NTHREADS) { sdst[s] = -1; sw[s] = 0.f; }
    LAS float* T = (LAS float*)(C.lds + TBL_OFF); { const int rb = stream_batch(C);
        for (int i = C.tid; i < 2 * 2048; i += NTHREADS) { const int set = i >> 11, col = i & 2047, r = set ? 4 : rb; T[(set * 2 + 0) * 2048 + col] = RG[r * 2048 + col]; T[(set * 2 + 1) * 2048 + col] = modp(C, l, r, 3)[col]; } }
    __syncthreads();
    f32x4 xa[8], xb[8]; float rsa = 0.f, rsb = 0.f; v2u ea = {0u, 0u}, eb = {0u, 0u}, pa = {0u, 0u}, pb = {0u, 0u}; float2 wa = {0.f, 0.f}, wb = {0.f, 0.f};
#define MG_LOAD(X, RS_, E, P, W, t) do { const int t_ = (t); RS_ = RS[t_]; E = *(const v2u*)(tokE + 2 * t_); P = *(const v2u*)(tokP + 2 * t_); W = *(const float2*)(tokW + 2 * t_); \
        _Pragma("unroll") for (int j = 0; j < 8; ++j) X[j] = *(const f32x4*)(XL + (size_t)t_ * D + C.lane * 4 + 256 * j); } while (0)
    const int NK = stream_nslots(C);
    int ta = stream_row(C, 0, nrows);
    if (ta >= 0) MG_LOAD(xa, rsa, ea, pa, wa, ta);
    for (int k = 0; k < NK; ++k) {
        const int tb = k + 1 < NK ? stream_row(C, k + 1, nrows) : -1;
        if (tb >= 0) MG_LOAD(xb, rsb, eb, pb, wb, tb);
        __builtin_amdgcn_sched_barrier(0);
        if (ta >= 0) {
            const int s0 = sh[__builtin_amdgcn_readfirstlane((int)ea.x)] + __builtin_amdgcn_readfirstlane((int)pa.x), s1 = sh[__builtin_amdgcn_readfirstlane((int)ea.y)] + __builtin_amdgcn_readfirstlane((int)pa.y);
            const LAS float* Ts = T + (ta < ML ? 0 : 2 * 2048) + C.lane * 4;
            unsigned char* d0 = XS + (size_t)s0 * D + C.lane * 4; unsigned char* d1 = XS + (size_t)s1 * D + C.lane * 4;
#pragma unroll
            for (int j = 0; j < 8; ++j) { const f32x4 gg = *(const LAS f32x4*)(Ts + 256 * j), shv = *(const LAS f32x4*)(Ts + 2048 + 256 * j);
                const f32x4 hv = xa[j] * rsa * gg + shv; const unsigned o = pg8::cvt4_fp8(hv.x, hv.y, hv.z, hv.w); *(unsigned*)(d0 + 256 * j) = o; *(unsigned*)(d1 + 256 * j) = o; }
            if (C.lane == 0) { sdst[s0] = 2 * ta; sw[s0] = wa.x; sdst[s1] = 2 * ta + 1; sw[s1] = wa.y; }
        }
#pragma unroll
        for (int j = 0; j < 8; ++j) xa[j] = xb[j];
        rsa = rsb; ea = eb; pa = pb; wa = wb; ta = tb;
        __builtin_amdgcn_sched_barrier(0);
    }
#undef MG_LOAD
    __syncthreads();
}
__device__ __forceinline__ void ph_final(const Args& a, const Ctx& C) {
    const float* XL = (const float*)(C.ws + WS_XL); const unsigned char* Y = (const unsigned char*)(C.ws + WS_Y); float* out = (float*)AIN(25);
    LAS float* T = (LAS float*)(C.lds + TBL_OFF); { const int rb = stream_batch(C); const float* gf = AIN(I_GFIN);
        for (int i = C.tid; i < 2048; i += NTHREADS) { T[i] = modp(C, DEPTH - 1, rb, 5)[i] * (1.f / pg8::F8_SCY); T[2048 + i] = gf[i]; } }
    __syncthreads();
    f32x4 va[8], vb[8]; int pa[8], qa[8], pb[8], qb[8];
#define FN_LOAD(V, P, Q, rw) do { const int rw_ = (rw); const unsigned char* y0_ = Y + (size_t)(2 * rw_) * D; \
        _Pragma("unroll") for (int j = 0; j < 8; ++j) { V[j] = *(const f32x4*)(XL + (size_t)rw_ * D + C.lane * 4 + 256 * j); P[j] = *(const int*)(y0_ + C.lane * 4 + 256 * j); Q[j] = *(const int*)(y0_ + D + C.lane * 4 + 256 * j); } } while (0)
    const int NK = stream_nslots(C);
    int rowa = stream_row(C, 0, ML);
    if (rowa >= 0) FN_LOAD(va, pa, qa, rowa);
    for (int k = 0; k < NK; ++k) {
        const int rowb = k + 1 < NK ? stream_row(C, k + 1, ML) : -1;
        if (rowb >= 0) FN_LOAD(vb, pb, qb, rowb);
        __builtin_amdgcn_sched_barrier(0);
        if (rowa >= 0) {
            const LAS float* Ts = T + C.lane * 4; float ss = 0.f;
#pragma unroll
            for (int j = 0; j < 8; ++j) { const f32x4 g = *(const LAS f32x4*)(Ts + 256 * j);
                va[j] = va[j] + g * (un4_fp8(pa[j]) + un4_fp8(qa[j]));
                ss += (va[j].x * va[j].x + va[j].y * va[j].y) + (va[j].z * va[j].z + va[j].w * va[j].w); }
            const float rs = rsqrtf(wave_sum(ss) * (1.f / D) + EPS);
#pragma unroll
            for (int j = 0; j < 8; ++j) { const f32x4 g = *(const LAS f32x4*)(Ts + 2048 + 256 * j); *(f32x4*)(out + (size_t)rowa * D + C.lane * 4 + 256 * j) = va[j] * rs * g; }
        }
        if (rowb >= 0) {
#pragma unroll
            for (int j = 0; j < 8; ++j) { va[j] = vb[j]; pa[j] = pb[j]; qa[j] = qb[j]; } }
        rowa = rowb;
        __builtin_amdgcn_sched_barrier(0);
    }
#undef FN_LOAD
}

constexpr int NPH = 2 + 10 * DEPTH;
#ifndef MK_ONE_LAUNCH
#define MK_ONE_LAUNCH 1
#endif
__global__ void __launch_bounds__(NTHREADS, 2) __attribute__((amdgpu_waves_per_eu(2, 2))) fwd(Args args) {
    extern __shared__ __attribute__((aligned(16))) unsigned char lds[];
    unsigned* ctl = (unsigned*)(args.ws + WS_CTL);
#define MKCTX() Ctx C; { int tz_ = threadIdx.x; asm volatile("" : "+v"(tz_)); size_t wo_ = 0; asm volatile("" : "+s"(wo_)); unsigned char* wz_ = args.ws + wo_; \
        C.lds = (LAS unsigned char*)lds; C.tid = tz_; C.lane = tz_ & 63; C.wave = __builtin_amdgcn_readfirstlane(tz_ >> 6); \
        C.G = gridDim.x; C.gw = blockIdx.x * NWAVES + C.wave; C.NGW = C.G * NWAVES; C.ws = wz_; C.mod = (float*)(C.ws + WS_CTL) + CW_MOD; }
    for (int u = threadIdx.x; u < (LDS_BYTES - LDSCTL_OFF) / 4; u += NTHREADS) ((LAS unsigned*)((LAS unsigned char*)lds + LDSCTL_OFF))[u] = 0u;
    __syncthreads();
    if (threadIdx.x < 26) { const unsigned long long off = (unsigned long long)((const char*)(threadIdx.x < 25 ? (const void*)args.in[threadIdx.x < 25 ? threadIdx.x : 0] : (const void*)args.out) - (const char*)args.ws);
        ((LAS unsigned long long*)((LAS unsigned char*)lds + ARGS_OFF))[threadIdx.x] = off; }
    __syncthreads();
#if MK_ONE_LAUNCH
    constexpr int lo = 0, hi = NPH;
#else
    const int lo = args.ph_lo, hi = args.ph_hi;
#endif
    XcdBarrier bar; bar.bar = ctl + CW_BAR; bar.x = 0; bar.st = nullptr;
    if (hi - lo > 1) bar = xcd_barrier_post(ctl + CW_BAR, (volatile LAS unsigned*)((LAS unsigned char*)lds + MISC_OFF) + 8);
#define IN(k) (lo <= (k) && (k) < hi)
#define SEAM(k) do { if (IN(k) && IN((k) + 1)) { XcdBarrier bl_ = bar; size_t z_ = 0; asm volatile("" : "+s"(z_)); bl_.bar = bar.bar + z_; bl_.x = xb_xcc_id(); xcd_barrier(bl_); } } while (0)

    if (IN(0)) { MKCTX(); { ph_mod(args, C); ph_conv_dense_w(args, C); ph_conv_expert_w(args, C, 0, true); __syncthreads(); } SEAM(0); }

#pragma unroll 1
    for (int l = 0; l < DEPTH; ++l) {
        const int pb = 1 + 10 * l; const bool last = (l == DEPTH - 1); const int nrows = last ? ML : MT;
        if (IN(pb + 0)) { MKCTX(); ph_norm1_tables(C, l); __syncthreads(); { if (l > 0) ph_conv_expert_w(args, C, l, false); } { ph_router_prep(args, C, l); ph_norm1(args, C, l); } SEAM(pb + 0); }
        if (IN(pb + 1)) {
            MKCTX();
            pg8::Gemm g{(const bf16*)(C.ws + WS_H), (const bf16*)(C.ws + WS_WIN) + (size_t)l * IN_DIM * D, MT, IN_DIM, D};
            pg8::InProjOrder S{C.G, (int)blockIdx.x}; pg8::EpiInProj E{(bf16*)(C.ws + WS_U), (bf16*)(C.ws + WS_VT)};
            pg8::gemm_phase<pg8::EpiInProj, pg8::InProjOrder, true, true>(C.lds + RING_OFF, g, S, E);
            SEAM(pb + 1); }
#ifndef DUP_HG
#define DUP_HG 1
#define DUP_CV 1
#define DUP_NA 1
#define DUP_RO 1
#define DUP_SC 1
#endif
        if (IN(pb + 2)) { MKCTX(); for (int rep_ = 0; rep_ < DUP_HG; ++rep_) { ph_hgrn_a(args, C, l); __syncthreads(); } conv_stage_w(args, C, l); __syncthreads(); for (int rep_ = 0; rep_ < DUP_CV; ++rep_) { ph_conv(args, C, l, nrows); } __syncthreads(); for (int rep_ = 0; rep_ < DUP_NA; ++rep_) { ph_attn_lds<true>(args, C, l); if (!last) ph_attn_lds<false>(args, C, l); } SEAM(pb + 2); }
        if (IN(pb + 3)) { MKCTX();
            for (int rep_ = 0; rep_ < DUP_SC; ++rep_) { ph_hgrn_scan(C); }
            SEAM(pb + 3); }
        if (IN(pb + 4)) { MKCTX(); for (int rep_ = 0; rep_ < DUP_RO; ++rep_) { ph_hgrn_readout(args, C, l, last); } SEAM(pb + 4); }
        if (IN(pb + 5)) {
            MKCTX();
            int kd = D; asm volatile("" : "+s"(kd));
            pg8::Gemm g{(const bf16*)(C.ws + WS_CAT), (const bf16*)(C.ws + WS_WOUT + (size_t)l * D * D), nrows, D, kd};
            pg8::StaticOrder S; S.init(nrows, D, C.G, (int)blockIdx.x);
            float* XL = (float*)(C.ws + WS_XL);
            pg8::EpiRes E{l == 0 ? AIN(I_X) : XL, l == 0 ? AIN(I_CTX) : XL + (size_t)ML * D, XL, C.mod + (size_t)l * 5 * 12288 + 2 * 2048};
            pg8::gemm_phase<pg8::EpiRes, pg8::StaticOrder, false, true, true>(C.lds + RING_OFF, g, S, E);
            SEAM(pb + 5); }
        if (IN(pb + 6)) { MKCTX(); { ph_norm2_router(args, C, l, nrows, true); } SEAM(pb + 6); }
        if (IN(pb + 7)) { MKCTX(); { ph_moe_gather(args, C, l, nrows); } SEAM(pb + 7); }
        if (IN(pb + 8)) {
            MKCTX();
            const int ntiles = __builtin_amdgcn_readfirstlane(*(const int*)(C.ws + WS_TAB + TB_NT));
            LAS int* tl = (LAS int*)(C.lds + TILE_LDS_OFF); if (C.tid < MOE_TILES_MAX) tl[C.tid] = ((const int*)(C.ws + WS_TAB + TB_TILEE))[C.tid < ntiles ? C.tid : 0]; __syncthreads();
            int kd = D; asm volatile("" : "+s"(kd));
            pg8::Gemm g{(const bf16*)(C.ws + WS_XS), (const bf16*)(C.ws + WS_WE1), ntiles * 256, 1024, kd};
            pg8::GroupedOrder S{tl, ntiles, 4, C.G, (int)blockIdx.x, (size_t)1024 * D};
            pg8::EpiGLU E{(unsigned char*)(C.ws + WS_ACT)};
            pg8::gemm_phase<pg8::EpiGLU, pg8::GroupedOrder, true, true, true>(C.lds + RING_OFF, g, S, E);
            SEAM(pb + 8); }
        if (IN(pb + 9)) {
            MKCTX();
            const int ntiles = __builtin_amdgcn_readfirstlane(*(const int*)(C.ws + WS_TAB + TB_NT));
            LAS int* tl = (LAS int*)(C.lds + TILE_LDS_OFF); if (C.tid < MOE_TILES_MAX) tl[C.tid] = ((const int*)(C.ws + WS_TAB + TB_TILEE))[C.tid < ntiles ? C.tid : 0]; __syncthreads();
            int kde = DE; asm volatile("" : "+s"(kde));
            pg8::Gemm g{(const bf16*)(C.ws + WS_ACT), (const bf16*)(C.ws + WS_WE2), ntiles * 256, D, kde};
            pg8::GroupedOrder S{tl, ntiles, 8, C.G, (int)blockIdx.x, (size_t)D * DE};
            pg8::EpiScatter E{(unsigned char*)(C.ws + WS_Y), (const int*)(C.ws + WS_TAB + TB_SDST), (const float*)(C.ws + WS_TAB + TB_SW)};
            pg8::gemm_phase<pg8::EpiScatter, pg8::GroupedOrder, false, false, true>(C.lds + RING_OFF, g, S, E);
            SEAM(pb + 9); }
    }
    if (IN(NPH - 1)) { MKCTX(); { ph_final(args, C); } }
#undef IN
#undef SEAM
}

extern "C" void kernel_launch(void* const* d_in, const int* in_sizes, int n_in, void* d_out, int out_size, void* d_ws, size_t ws_size, hipStream_t stream) {
    static int grid = 0;
    if (grid == 0) {
        if (n_in != 25 || in_sizes[0] != ML * D || out_size != ML * D || ws_size < WS_END) {
            fprintf(stderr, "kernel_launch: unexpected shapes: n_in %d in0 %d out %d ws %zu (need %zu)\n", n_in, n_in > 0 ? in_sizes[0] : -1, out_size, ws_size, (size_t)WS_END); grid = -1; return; }
        int dev = 0, cus = 0, per_cu = 0;
        if (hipGetDevice(&dev) != hipSuccess || hipDeviceGetAttribute(&cus, hipDeviceAttributeMultiprocessorCount, dev) != hipSuccess) { grid = -1; return; }
        if (hipFuncSetAttribute((const void*)fwd, hipFuncAttributeMaxDynamicSharedMemorySize, LDS_BYTES) != hipSuccess) { fprintf(stderr, "kernel_launch: hipFuncSetAttribute failed\n"); grid = -1; return; }
        if (hipOccupancyMaxActiveBlocksPerMultiprocessor(&per_cu, (const void*)fwd, NTHREADS, LDS_BYTES) != hipSuccess || per_cu < 1)
            fprintf(stderr, "kernel_launch: note: occupancy query reports %d workgroups per CU\n", per_cu);
        (void)hipGetLastError();
        grid = cus & ~7;
    }
    if (grid < 0) return;
    if (hipMemsetAsync((char*)d_ws + WS_CTL, 0, CTL_ZERO_BYTES, stream) != hipSuccess) { fprintf(stderr, "kernel_launch: memset failed\n"); return; }
    Args a{};
    for (int i = 0; i < 25; ++i) a.in[i] = (const float*)d_in[i];
    a.out = (float*)d_out; a.ws = (unsigned char*)d_ws;
#if MK_ONE_LAUNCH
    a.ph_lo = 0; a.ph_hi = NPH;
    hipLaunchKernelGGL(fwd, dim3(grid), dim3(NTHREADS), LDS_BYTES, stream, a);
#else
    for (int ph = 0; ph < NPH; ++ph) { a.ph_lo = ph; a.ph_hi = ph + 1; hipLaunchKernelGGL(fwd, dim3(grid), dim3(NTHREADS), LDS_BYTES, stream, a); }
#endif
    const hipError_t le = hipPeekAtLastError();
    if (le != hipSuccess) fprintf(stderr, "kernel_launch: launch failed: %s\n", hipGetErrorName(le));
}
```
